# Optimizing an MI355X kernel written in HIP

```python
import math
import jax, jax.numpy as jnp
from jax import lax
import numpy as np

D_MODEL = 1024
BATCH = 8
SEQ = 4096
DEPTH = 4

N_MIXERS = 3
HEAD_DIM = 64
N_HEADS = D_MODEL // HEAD_DIM
MIX_WIDTH = N_HEADS * HEAD_DIM
ROT_DIM = HEAD_DIM // 4
ROPE_THETA = 500000.0
Q_BLOCK = 128
IDX_HEADS = 8
IDX_DIM = 64
IDX_ROT = IDX_DIM // 4
TOPK_MAX = 256
DSA_BLOCK = 32
FOX_HEADS = N_HEADS
MLA_HEADS = N_HEADS
MLA_NOPE = 64
MLA_ROPE = 32
MLA_V = 64
Q_LORA = 384
KV_LORA = 256
D_FF = 2816
ALPHA = (2.0 * DEPTH) ** 0.25
BETA = (8.0 * DEPTH) ** -0.25
LN_EPS = 1e-5
RMS_EPS = 1e-6
N_DSA = (DEPTH + 2) // 3
N_FOX = (DEPTH + 1) // 3
N_MLA = DEPTH // 3
DSA_IN = 3 * MIX_WIDTH + IDX_HEADS * IDX_DIM + IDX_DIM + IDX_HEADS
FOX_IN = 3 * MIX_WIDTH + FOX_HEADS
MLA_IN = Q_LORA + KV_LORA + MLA_ROPE

kernel_name = "hybrid_dsa_fox_mla_macaron_deepnorm"


def layer_norm(x, g, b):
    xf = x.astype(jnp.float32)
    mu = jnp.mean(xf, axis=-1, keepdims=True)
    var = jnp.mean(jnp.square(xf - mu), axis=-1, keepdims=True)
    return ((xf - mu) * lax.rsqrt(var + LN_EPS) * g.astype(jnp.float32) + b.astype(jnp.float32)).astype(x.dtype)


def rms_norm(x, g):
    xf = x.astype(jnp.float32)
    ms = jnp.mean(jnp.square(xf), axis=-1, keepdims=True)
    return (xf * lax.rsqrt(ms + RMS_EPS) * g.astype(jnp.float32)).astype(x.dtype)


def rope_tables(seq_len, dim):
    inv = ROPE_THETA ** (-jnp.arange(0, dim, 2, dtype=jnp.float32) / dim)
    ang = jnp.arange(seq_len, dtype=jnp.float32)[:, None] * inv[None, :]
    return jnp.cos(ang), jnp.sin(ang)


def apply_rope(x, cos, sin):
    half = x.shape[-1] // 2
    x1, x2 = x[..., :half], x[..., half:]
    c = cos[None, :, None, :].astype(x.dtype)
    s = sin[None, :, None, :].astype(x.dtype)
    return jnp.concatenate([x1 * c - x2 * s, x1 * s + x2 * c], axis=-1)


def partial_rope(x, cos, sin, rot):
    return jnp.concatenate([apply_rope(x[..., :rot], cos, sin), x[..., rot:]], axis=-1)


def swiglu(x, w13, w2):
    gate, up = jnp.split(x @ w13, 2, axis=-1)
    return (jax.nn.silu(gate) * up) @ w2


def causal_block_attention(q, k, v, scale, cum=None):
    S = q.shape[1]
    outs = []
    for i in range(S // Q_BLOCK):
        lo, hi = i * Q_BLOCK, (i + 1) * Q_BLOCK
        s = jnp.einsum('bqhd,bkhd->bhqk', q[:, lo:hi], k[:, :hi]).astype(jnp.float32) * scale
        if cum is not None:
            s = s + cum[:, :, lo:hi, None] - cum[:, :, None, :hi]
        mask = jnp.arange(lo, hi)[:, None] >= jnp.arange(hi)[None, :]
        p = jax.nn.softmax(jnp.where(mask, s, -jnp.inf), axis=-1).astype(v.dtype)
        outs.append(jnp.einsum('bhqk,bkhd->bqhd', p, v[:, :hi]))
    return jnp.concatenate(outs, axis=1)


def dsa_mixer(x, w_in, w_out, cos_p, sin_p):
    B, S, _ = x.shape
    d = MIX_WIDTH
    di = IDX_HEADS * IDX_DIM
    q, k, v, qi, ki, wi = jnp.split(x @ w_in, [d, 2 * d, 3 * d, 3 * d + di, 3 * d + di + IDX_DIM], axis=-1)
    q = partial_rope(q.reshape(B, S, N_HEADS, HEAD_DIM), cos_p, sin_p, ROT_DIM)
    k = partial_rope(k.reshape(B, S, N_HEADS, HEAD_DIM), cos_p, sin_p, ROT_DIM)
    v = v.reshape(B, S, N_HEADS, HEAD_DIM)
    qi = partial_rope(qi.reshape(B, S, IDX_HEADS, IDX_DIM), cos_p, sin_p, IDX_ROT)
    ki = partial_rope(ki.reshape(B, S, 1, IDX_DIM), cos_p, sin_p, IDX_ROT)[:, :, 0]
    wi = wi.astype(jnp.float32) * (IDX_HEADS ** -0.5)
    topk = min(TOPK_MAX, S // 4)
    scale = HEAD_DIM ** -0.5
    key_pos = jnp.arange(S)

    def block(i):
        lo = i * DSA_BLOCK
        t = lo + jnp.arange(DSA_BLOCK)
        qb = lax.dynamic_slice_in_dim(q, lo, DSA_BLOCK, axis=1)
        qib = lax.dynamic_slice_in_dim(qi, lo, DSA_BLOCK, axis=1)
        wib = lax.dynamic_slice_in_dim(wi, lo, DSA_BLOCK, axis=1)
        dots = jnp.einsum('bqhd,bkd->bqhk', qib, ki).astype(jnp.float32) * (IDX_DIM ** -0.5)
        idx_score = jnp.einsum('bqh,bqhk->bqk', wib, jax.nn.relu(dots))
        idx_score = jnp.where(t[:, None] >= key_pos[None, :], idx_score, -jnp.inf)
        _, sel = lax.top_k(idx_score, topk)
        ks = jax.vmap(lambda kk, ii: kk[ii])(k, sel)
        vs = jax.vmap(lambda vv, ii: vv[ii])(v, sel)
        logits = jnp.einsum('bqhd,bqkhd->bhqk', qb, ks).astype(jnp.float32) * scale
        valid = sel <= t[None, :, None]
        p = jax.nn.softmax(jnp.where(valid[:, None], logits, -jnp.inf), axis=-1).astype(v.dtype)
        return jnp.einsum('bhqk,bqkhd->bqhd', p, vs)

    out = lax.map(block, jnp.arange(S // DSA_BLOCK))
    out = jnp.transpose(out, (1, 0, 2, 3, 4)).reshape(B, S, d)
    return out @ w_out


def fox_mixer(x, w_in, b_f, w_out):
    B, S, _ = x.shape
    d = MIX_WIDTH
    q, k, v, f = jnp.split(x @ w_in, [d, 2 * d, 3 * d], axis=-1)
    q = q.reshape(B, S, FOX_HEADS, HEAD_DIM)
    k = k.reshape(B, S, FOX_HEADS, HEAD_DIM)
    v = v.reshape(B, S, FOX_HEADS, HEAD_DIM)
    log_f = jax.nn.log_sigmoid(f.astype(jnp.float32) + b_f.astype(jnp.float32))
    cum = jnp.transpose(jnp.cumsum(log_f, axis=1), (0, 2, 1))
    o = causal_block_attention(q, k, v, HEAD_DIM ** -0.5, cum)
    return o.reshape(B, S, d) @ w_out


def mla_mixer(x, w_dqkv, q_norm_g, w_uq, kv_norm_g, w_ukv, w_out, cos_m, sin_m):
    B, S, _ = x.shape
    cq, ckv, k_rope = jnp.split(x @ w_dqkv, [Q_LORA, Q_LORA + KV_LORA], axis=-1)
    q = (rms_norm(cq, q_norm_g) @ w_uq).reshape(B, S, MLA_HEADS, MLA_NOPE + MLA_ROPE)
    q_nope, q_rope = q[..., :MLA_NOPE], apply_rope(q[..., MLA_NOPE:], cos_m, sin_m)
    kv = (rms_norm(ckv, kv_norm_g) @ w_ukv).reshape(B, S, MLA_HEADS, MLA_NOPE + MLA_V)
    k_nope, v = kv[..., :MLA_NOPE], kv[..., MLA_NOPE:]
    k_rope = apply_rope(k_rope[:, :, None, :], cos_m, sin_m)
    q = jnp.concatenate([q_nope, q_rope], axis=-1)
    k = jnp.concatenate([k_nope, jnp.broadcast_to(k_rope, (B, S, MLA_HEADS, MLA_ROPE))], axis=-1)
    o = causal_block_attention(q, k, v, (MLA_NOPE + MLA_ROPE) ** -0.5)
    return o.reshape(B, S, MLA_HEADS * MLA_V) @ w_out


def setup_inputs(seed: int = 0) -> dict:
    key = jax.random.key(seed)
    ks = jax.random.split(key, 20)
    nrm = lambda k, shape, fan_in, s=1.0: jax.random.normal(k, shape, jnp.float32) * (fan_in ** -0.5) * s
    x = jax.random.normal(ks[0], (BATCH, SEQ, D_MODEL), jnp.float32)
    ffn1_w13 = nrm(ks[1], (DEPTH, D_MODEL, 2 * D_FF), D_MODEL)
    ffn1_w2 = nrm(ks[2], (DEPTH, D_FF, D_MODEL), D_FF, BETA)
    ffn2_w13 = nrm(ks[3], (DEPTH, D_MODEL, 2 * D_FF), D_MODEL)
    ffn2_w2 = nrm(ks[4], (DEPTH, D_FF, D_MODEL), D_FF, BETA)
    ln_g = 1.0 + 0.02 * jax.random.normal(ks[5], (DEPTH, 3, D_MODEL), jnp.float32)
    ln_b = 0.02 * jax.random.normal(ks[6], (DEPTH, 3, D_MODEL), jnp.float32)
    w_out = nrm(ks[7], (DEPTH, MIX_WIDTH, D_MODEL), MIX_WIDTH, BETA)
    dsa_w_in = nrm(ks[8], (N_DSA, D_MODEL, DSA_IN), D_MODEL)
    fox_w_in = nrm(ks[9], (N_FOX, D_MODEL, FOX_IN), D_MODEL)
    fox_b_f = (jnp.broadcast_to(jnp.linspace(1.0, 6.0, FOX_HEADS, dtype=jnp.float32), (N_FOX, FOX_HEADS))
               + 0.1 * jax.random.normal(ks[10], (N_FOX, FOX_HEADS), jnp.float32))
    mla_w_dqkv = nrm(ks[11], (N_MLA, D_MODEL, MLA_IN), D_MODEL)
    mla_q_norm_g = 1.0 + 0.02 * jax.random.normal(ks[12], (N_MLA, Q_LORA), jnp.float32)
    mla_w_uq = nrm(ks[13], (N_MLA, Q_LORA, MLA_HEADS * (MLA_NOPE + MLA_ROPE)), Q_LORA)
    mla_kv_norm_g = 1.0 + 0.02 * jax.random.normal(ks[14], (N_MLA, KV_LORA), jnp.float32)
    mla_w_ukv = nrm(ks[15], (N_MLA, KV_LORA, MLA_HEADS * (MLA_NOPE + MLA_V)), KV_LORA)
    return {"x": x, "ffn1_w13": ffn1_w13, "ffn1_w2": ffn1_w2, "ffn2_w13": ffn2_w13, "ffn2_w2": ffn2_w2,
            "ln_g": ln_g, "ln_b": ln_b, "w_out": w_out, "dsa_w_in": dsa_w_in, "fox_w_in": fox_w_in,
            "fox_b_f": fox_b_f, "mla_w_dqkv": mla_w_dqkv, "mla_q_norm_g": mla_q_norm_g,
            "mla_w_uq": mla_w_uq, "mla_kv_norm_g": mla_kv_norm_g, "mla_w_ukv": mla_w_ukv}


def reference(x, ffn1_w13, ffn1_w2, ffn2_w13, ffn2_w2, ln_g, ln_b, w_out, dsa_w_in, fox_w_in,
              fox_b_f, mla_w_dqkv, mla_q_norm_g, mla_w_uq, mla_kv_norm_g, mla_w_ukv):
    S = x.shape[1]
    cos_p, sin_p = rope_tables(S, ROT_DIM)
    cos_m, sin_m = rope_tables(S, MLA_ROPE)
    for i in range(DEPTH):
        x = layer_norm(ALPHA * x + 0.5 * swiglu(x, ffn1_w13[i], ffn1_w2[i]), ln_g[i, 0], ln_b[i, 0])
        kind, j = i % N_MIXERS, i // N_MIXERS
        if kind == 0:
            y = dsa_mixer(x, dsa_w_in[j], w_out[i], cos_p, sin_p)
        elif kind == 1:
            y = fox_mixer(x, fox_w_in[j], fox_b_f[j], w_out[i])
        else:
            y = mla_mixer(x, mla_w_dqkv[j], mla_q_norm_g[j], mla_w_uq[j], mla_kv_norm_g[j],
                          mla_w_ukv[j], w_out[i], cos_m, sin_m)
        x = layer_norm(ALPHA * x + y, ln_g[i, 1], ln_b[i, 1])
        x = layer_norm(ALPHA * x + 0.5 * swiglu(x, ffn2_w13[i], ffn2_w2[i]), ln_g[i, 2], ln_b[i, 2])
    return x
```

```cpp
#include <hip/hip_runtime.h>
#include <hip/hip_cooperative_groups.h>
#include <cstdio>
#include <cstdint>
namespace cg = cooperative_groups;
#ifndef MK_MULTI
#define MK_MULTI 0
#endif
typedef __bf16 bf2_t __attribute__((ext_vector_type(2)));
typedef float f32x2_t __attribute__((ext_vector_type(2)));
__device__ __forceinline__ unsigned pk_bf16(float lo, float hi) { f32x2_t v = {lo, hi}; return __builtin_bit_cast(unsigned, __builtin_convertvector(v, bf2_t)); }
__device__ __forceinline__ float bf_lo(unsigned w) { return __uint_as_float(w << 16); }
__device__ __forceinline__ float bf_hi(unsigned w) { return __uint_as_float(w & 0xffff0000u); }
#define LOG2E 1.4426950408889634f
namespace pg8 {
#define PG8_LAS __attribute__((address_space(3)))
typedef unsigned short bf16_t;
typedef short bf16x8 __attribute__((ext_vector_type(8)));
typedef float f32x4 __attribute__((ext_vector_type(4)));
typedef unsigned u32x4 __attribute__((ext_vector_type(4)));
constexpr int BM = 256, BK = 64, HALF = 128, HTB = HALF * BK * 2  , STAGE_BYTES = 8 * HTB, NXCD = 8, WGM = 8;

__host__ __device__ __forceinline__ int lds_byte(int r, int c) { const int st = (r >> 4) * 2 + (c >> 5), rr = r & 15, cc = c & 31, ob = rr * 64 + cc * 2; return st * 1024 + (ob ^ (((ob >> 9) & 1) << 5)); }
__host__ __device__ __forceinline__ void stage_rc(int b, int& R, int& C) { const int st = b / 1024, sb = b % 1024, swz = sb ^ (((sb >> 9) & 1) << 5); R = (st >> 1) * 16 + swz / 64; C = (st & 1) * 32 + (swz % 64) / 2; }
__host__ __device__ __forceinline__ int perm32(int rho) { const int n = rho >> 4, i = rho & 15; return 8 * (i >> 2) + 4 * n + (i & 3); }

struct Unit { int pm, pn; };
struct Gemm { const bf16_t* A; const bf16_t* Bt; int M, N, K; };

struct StaticOrder {
    int nM, nN, nwg, G, c;
    __host__ __device__ void init(int M, int N, int G_, int c_) { nM = M / BM; nN = N / BM; nwg = nM * nN; G = G_; c = c_; }
    __host__ __device__ bool next(int i, Unit& u) const {
        const long L = (long)i * G + c; if (L >= nwg) return false;
        int wgid = (int)L; { const int q = nwg / NXCD, r = nwg % NXCD, xcd = wgid % NXCD, off = wgid / NXCD; wgid = (xcd < r ? xcd * (q + 1) : r * (q + 1) + (xcd - r) * q) + off; }
        const int nig = WGM * nN, gid = wgid / nig, fm = gid * WGM, gsz = (nM - fm) < WGM ? (nM - fm) : WGM;
        u.pm = fm + ((wgid % nig) % gsz); u.pn = (wgid % nig) / gsz; return true;
    }
    __device__ __forceinline__ void a_ready(const Unit&) const {}
    __device__ __forceinline__ void done(const Unit&) const {}
};
__device__ __forceinline__ unsigned cvt_pk_bf16(float lo, float hi) { unsigned r; asm volatile("v_cvt_pk_bf16_f32 %0, %1, %2" : "=v"(r) : "v"(lo), "v"(hi)); return r; }
typedef float f32x2 __attribute__((ext_vector_type(2)));
__device__ __forceinline__ float silu_f(float x) { return x * __builtin_amdgcn_rcpf(1.0f + __builtin_amdgcn_exp2f(-x * LOG2E)); }
struct EpiSwiglu {
    static constexpr bool PERM = true, AFTER_DRAIN = false;
    bf16_t* H;
    __device__ __forceinline__ void operator()(const f32x4 (&acc)[2][2][4][2], const Unit& u, int wr, int wc, int fr, int fq) const {
        const int row0 = u.pm * BM + wr * 64 + fr, col0 = u.pn * 128 + wc * 32 + 8 * fq;
#pragma unroll
        for (int ai = 0; ai < 2; ++ai)
#pragma unroll
            for (int m = 0; m < 4; ++m) {
                bf16_t* rowp = H + (size_t)(row0 + ai * HALF + m * 16) * 2816 + col0;
                const f32x4 g0 = acc[ai][0][m][0], g1 = acc[ai][0][m][1], u0 = acc[ai][1][m][0], u1 = acc[ai][1][m][1];
                u32x4 w;
                w.x = pk_bf16(silu_f(g0[0]) * u0[0], silu_f(g0[1]) * u0[1]); w.y = pk_bf16(silu_f(g0[2]) * u0[2], silu_f(g0[3]) * u0[3]);
                w.z = pk_bf16(silu_f(g1[0]) * u1[0], silu_f(g1[1]) * u1[1]); w.w = pk_bf16(silu_f(g1[2]) * u1[2], silu_f(g1[3]) * u1[3]);
                *(u32x4*)rowp = w;
            }
    }
};
struct EpiResid {
    static constexpr bool PERM = false, AFTER_DRAIN = false;
    float* X; float alpha, s;
    __device__ __forceinline__ void operator()(const f32x4 (&acc)[2][2][4][2], const Unit& u, int wr, int wc, int fr, int fq) const {
        const int row0 = u.pm * BM + wr * 64 + fr, col0 = u.pn * BM + wc * 32 + 4 * fq;
#pragma unroll
        for (int ai = 0; ai < 2; ++ai)
#pragma unroll
            for (int m = 0; m < 4; ++m) {
                float* rowp = X + (size_t)(row0 + ai * HALF + m * 16) * 1024 + col0;
#pragma unroll
                for (int bj = 0; bj < 2; ++bj)
#pragma unroll
                    for (int n = 0; n < 2; ++n) { f32x4* p = (f32x4*)(rowp + bj * HALF + n * 16); const f32x4 x = *p; *p = x * alpha + acc[ai][bj][m][n] * s; }
            }
    }
};
struct EpiProj {
    static constexpr bool PERM = true, AFTER_DRAIN = false;
    int mode;
    bf16_t *QO, *KB, *VB, *X0, *KI; float* F0; const float* bfox; const float* csp; const float* csm; float qscale, wscale;
    __device__ __forceinline__ void store(const f32x4 (&acc)[2][2][4][2], bf16_t* dst, int ld, int cb, float sc, int rope, const float* cs, int nbj, int row0, int wc, int fq) const {
        const bool rot = (rope == 2) || (rope == 1 && !(wc & 1) && fq < 2);
        const int nd = (rope == 2) ? 16 : 8;
#pragma unroll
        for (int ai = 0; ai < 2; ++ai)
#pragma unroll
            for (int m = 0; m < 4; ++m) {
                const int row = row0 + ai * HALF + m * 16, t = row & 4095;
                f32x4 c01 = {1.f, 0.f, 1.f, 0.f}, c23 = {1.f, 0.f, 1.f, 0.f};
                if (rot) { const f32x4* tp = (const f32x4*)(cs + ((size_t)t * nd + 4 * fq) * 2); c01 = tp[0]; c23 = tp[1]; }
#pragma unroll
                for (int bj = 0; bj < 2; ++bj) if (bj < nbj) {
                    f32x4 v0 = acc[ai][bj][m][0], v1 = acc[ai][bj][m][1];
                    if (rot) {
                        f32x4 r0, r1;
                        r0[0] = v0[0] * c01[0] - v0[1] * c01[1]; r0[1] = v0[0] * c01[1] + v0[1] * c01[0];
                        r0[2] = v0[2] * c01[2] - v0[3] * c01[3]; r0[3] = v0[2] * c01[3] + v0[3] * c01[2];
                        r1[0] = v1[0] * c23[0] - v1[1] * c23[1]; r1[1] = v1[0] * c23[1] + v1[1] * c23[0];
                        r1[2] = v1[2] * c23[2] - v1[3] * c23[3]; r1[3] = v1[2] * c23[3] + v1[3] * c23[2];
                        v0 = r0; v1 = r1;
                    }
                    v0 = v0 * sc; v1 = v1 * sc;
                    u32x4 w; w.x = pk_bf16(v0[0], v0[1]); w.y = pk_bf16(v0[2], v0[3]); w.z = pk_bf16(v1[0], v1[1]); w.w = pk_bf16(v1[2], v1[3]);
                    *(u32x4*)(dst + (size_t)row * ld + cb + bj * HALF + wc * 32 + 8 * fq) = w;
                }
            }
    }
    __device__ __forceinline__ void operator()(const f32x4 (&acc)[2][2][4][2], const Unit& u, int wr, int wc, int fr, int fq) const {
        const int pn = u.pn, row0 = u.pm * BM + wr * 64 + fr;
        if (mode == 1) {
            if (pn < 4) store(acc, QO, 1024, pn * 256, qscale, 1, csp, 2, row0, wc, fq);
            else if (pn < 8) store(acc, KB, 1024, (pn - 4) * 256, 1.f, 1, csp, 2, row0, wc, fq);
            else if (pn < 12) store(acc, VB, 1024, (pn - 8) * 256, 1.f, 0, csp, 2, row0, wc, fq);
            else if (pn < 14) store(acc, X0, 512, (pn - 12) * 256, 1.f, 1, csp, 2, row0, wc, fq);
            else {
                if (wc < 2) store(acc, KI, 64, 0, 1.f, 1, csp, 1, row0, wc, fq);
                else if (wc == 2 && fq == 0) {
#pragma unroll
                    for (int ai = 0; ai < 2; ++ai)
#pragma unroll
                        for (int m = 0; m < 4; ++m) { float* wp = F0 + (size_t)(row0 + ai * HALF + m * 16) * 8;
                            *(f32x4*)wp = acc[ai][0][m][0] * wscale; *(f32x4*)(wp + 4) = acc[ai][0][m][1] * wscale; }
                }
            }
        } else if (mode == 2) {
            if (pn < 4) store(acc, QO, 1024, pn * 256, qscale, 0, csp, 2, row0, wc, fq);
            else if (pn < 8) store(acc, KB, 1024, (pn - 4) * 256, 1.f, 0, csp, 2, row0, wc, fq);
            else if (pn < 12) store(acc, VB, 1024, (pn - 8) * 256, 1.f, 0, csp, 2, row0, wc, fq);
            else if (wc == 0 && fq < 2) {
                const f32x4 b0 = *(const f32x4*)(bfox + 8 * fq), b1 = *(const f32x4*)(bfox + 8 * fq + 4);
#pragma unroll
                for (int ai = 0; ai < 2; ++ai)
#pragma unroll
                    for (int m = 0; m < 4; ++m) { float* lp = F0 + (size_t)(row0 + ai * HALF + m * 16) * 16 + 8 * fq;
                        const f32x4 z0 = acc[ai][0][m][0] + b0, z1 = acc[ai][0][m][1] + b1; f32x4 o0, o1;
#pragma unroll
                        for (int e = 0; e < 4; ++e) { o0[e] = (fminf(z0[e], 0.f) - log1pf(expf(-fabsf(z0[e])))) * LOG2E; o1[e] = (fminf(z1[e], 0.f) - log1pf(expf(-fabsf(z1[e])))) * LOG2E; }
                        *(f32x4*)lp = o0; *(f32x4*)(lp + 4) = o1; }
            }
        } else if (mode == 3) {
            store(acc, X0, 768, pn * 256, 1.f, 0, csp, 2, row0, wc, fq);
        } else if (mode == 4) {
            if (pn < 4) store(acc, QO, 1024, pn * 256, qscale, 0, csm, 2, row0, wc, fq);
            else store(acc, X0, 512, (pn - 4) * 256, qscale, 2, csm, 2, row0, wc, fq);
        } else {
            if (pn < 4) store(acc, KB, 1024, pn * 256, 1.f, 0, csp, 2, row0, wc, fq);
            else store(acc, VB, 1024, (pn - 4) * 256, 1.f, 0, csp, 2, row0, wc, fq);
        }
    }
};
template <class Epi, class Sched, bool ALIGN_EPI = false, bool SP2 = false>
__device__ __forceinline__ void gemm_phase(PG8_LAS unsigned char* lds, const Gemm g, const Sched& S, const Epi& E) {
    int tid_ = threadIdx.x; asm volatile("" : "+v"(tid_)); const int tid = tid_, wid = __builtin_amdgcn_readfirstlane(tid >> 6), lane = tid & 63, wr = wid >> 2, wc = wid & 3, fr = lane & 15, fq = lane >> 4;
    const int K = g.K, nt = K / BK;
    unsigned voffA[2], voffB[2];
#pragma unroll
    for (int i = 0; i < 2; ++i) { int R, C; stage_rc(tid * 16 + i * 8192, R, C); const int Rb = Epi::PERM ? ((R & ~31) + perm32(R & 31)) : R;
        voffA[i] = (unsigned)(R * K + C) * 2u; voffB[i] = (unsigned)(Rb * K + C) * 2u; }
    const size_t kstep = (size_t)(BK * 2);
    const size_t hstep = (size_t)HALF * K * 2;
    const size_t tstep = 2 * hstep;
    const unsigned ldsw = (unsigned)wid * 1024u;
    const int aoff = lds_byte(wr * 64 + fr, fq * 8), boff = lds_byte(wc * 32 + fr, fq * 8);
#define PG8_SA(b, h) (((b) * 2 + (h)) * HTB)
#define PG8_SB(b, h) ((4 + (b) * 2 + (h)) * HTB)
#define PG8_STAGE(bufoff, gbase, voff) do { _Pragma("unroll") for (int _i = 0; _i < 2; ++_i) \
        __builtin_amdgcn_global_load_lds((const unsigned*)((const char*)(gbase) + (voff)[_i]), (PG8_LAS unsigned*)(lds + (bufoff) + ldsw + _i * 8192), 16, 0, 0); } while (0)
#define PG8_LDA(dst, b, h) do { _Pragma("unroll") for (int m = 0; m < 4; ++m) _Pragma("unroll") for (int k = 0; k < 2; ++k) dst[m][k] = *(const PG8_LAS bf16x8*)(lds + PG8_SA(b, h) + aoff + m * 2048 + k * 1024); } while (0)
#define PG8_LDB(dst, b, h) do { _Pragma("unroll") for (int n = 0; n < 2; ++n) _Pragma("unroll") for (int k = 0; k < 2; ++k) dst[n][k] = *(const PG8_LAS bf16x8*)(lds + PG8_SB(b, h) + boff + n * 2048 + k * 1024); } while (0)
#define PG8_MMA(ai, bj, At, Bt) do { __builtin_amdgcn_s_setprio(1); _Pragma("unroll") for (int m = 0; m < 4; ++m) _Pragma("unroll") for (int n = 0; n < 2; ++n) _Pragma("unroll") for (int k = 0; k < 2; ++k) \
        acc[ai][bj][m][n] = __builtin_amdgcn_mfma_f32_16x16x32_bf16(Bt[n][k], At[m][k], acc[ai][bj][m][n], 0, 0, 0); __builtin_amdgcn_s_setprio(0); } while (0)
#define PG8_WAIT_V(n) asm volatile("s_waitcnt vmcnt(" #n ")" ::: "memory")
#define PG8_WAIT_L(n) asm volatile("s_waitcnt lgkmcnt(" #n ")" ::: "memory")
#define PG8_BAR __builtin_amdgcn_s_barrier()
#define PG8_SCHED __builtin_amdgcn_sched_barrier(0)
    Unit cur, nxt; int ui = 0;
    if (!S.next(0, cur)) return;
    f32x4 acc[2][2][4][2];
#pragma unroll
    for (int a = 0; a < 2; ++a)
#pragma unroll
        for (int b = 0; b < 2; ++b)
#pragma unroll
            for (int m = 0; m < 4; ++m)
#pragma unroll
                for (int n = 0; n < 2; ++n) acc[a][b][m][n] = (f32x4){0.f, 0.f, 0.f, 0.f};
    bf16x8 At[4][2], B0[2][2], B1[2][2];
    const char* cA = (const char*)g.A + (size_t)cur.pm * tstep; const char* cB = (const char*)g.Bt + (size_t)cur.pn * tstep;
    S.a_ready(cur);
    if constexpr (SP2) {
        PG8_STAGE(PG8_SB(0, 0), cB, voffB); PG8_STAGE(PG8_SB(0, 1), cB + hstep, voffB); PG8_STAGE(PG8_SA(0, 0), cA, voffA); PG8_STAGE(PG8_SA(0, 1), cA + hstep, voffA);
        if (wr == 1) PG8_BAR;
        PG8_WAIT_V(2); PG8_BAR;
        PG8_STAGE(PG8_SB(1, 0), cB + kstep, voffB); PG8_STAGE(PG8_SA(1, 0), cA + kstep, voffA); PG8_STAGE(PG8_SB(1, 1), cB + hstep + kstep, voffB);
        PG8_WAIT_V(6); PG8_BAR;
    } else {
        PG8_STAGE(PG8_SB(0, 0), cB, voffB); PG8_STAGE(PG8_SA(0, 0), cA, voffA); PG8_STAGE(PG8_SB(0, 1), cB + hstep, voffB); PG8_STAGE(PG8_SA(0, 1), cA + hstep, voffA);
        if (wr == 1) PG8_BAR;
        PG8_WAIT_V(4); PG8_BAR;
        PG8_STAGE(PG8_SB(1, 0), cB + kstep, voffB); PG8_STAGE(PG8_SA(1, 0), cA + kstep, voffA); PG8_STAGE(PG8_SB(1, 1), cB + hstep + kstep, voffB);
        PG8_WAIT_V(6); PG8_BAR;
    }
    for (;;) {
        const bool has_next = S.next(ui + 1, nxt);
        const char* nA = has_next ? (const char*)g.A + (size_t)nxt.pm * tstep : cA; const char* nB = has_next ? (const char*)g.Bt + (size_t)nxt.pn * tstep : cB;
        for (int t = 0; t < nt; t += 2) {
            const bool last = (t == nt - 2);
            const char* a1 = cA + (size_t)(t + 1) * kstep;
            const char* a2 = last ? nA : cA + (size_t)(t + 2) * kstep; const char* b2 = last ? nB : cB + (size_t)(t + 2) * kstep;
            const char* a3 = a2 + kstep; const char* b3 = b2 + kstep;
            if (last && has_next) S.a_ready(nxt);
            if constexpr (SP2) {
            PG8_LDB(B0, 0, 0); PG8_LDB(B1, 0, 1); PG8_SCHED; PG8_LDA(At, 0, 0); PG8_STAGE(PG8_SA(1, 1), a1 + hstep, voffA);
            PG8_WAIT_V(8); PG8_WAIT_L(0); PG8_BAR; PG8_MMA(0, 0, At, B0); PG8_MMA(0, 1, At, B1); PG8_BAR; PG8_SCHED;
            PG8_LDA(At, 0, 1); PG8_STAGE(PG8_SB(0, 0), b2, voffB); PG8_STAGE(PG8_SB(0, 1), b2 + hstep, voffB); PG8_STAGE(PG8_SA(0, 0), a2, voffA);
            PG8_WAIT_V(8); PG8_WAIT_L(0); PG8_BAR; PG8_MMA(1, 0, At, B0); PG8_MMA(1, 1, At, B1); PG8_BAR; PG8_SCHED;
            PG8_LDB(B0, 1, 0); PG8_LDB(B1, 1, 1); PG8_SCHED; PG8_LDA(At, 1, 0); PG8_STAGE(PG8_SA(0, 1), a2 + hstep, voffA);
            PG8_WAIT_V(8); PG8_WAIT_L(0); PG8_BAR; PG8_MMA(0, 0, At, B0); PG8_MMA(0, 1, At, B1); PG8_BAR; PG8_SCHED;
            PG8_LDA(At, 1, 1); PG8_STAGE(PG8_SB(1, 0), b3, voffB); PG8_STAGE(PG8_SB(1, 1), b3 + hstep, voffB); PG8_STAGE(PG8_SA(1, 0), a3, voffA);
            PG8_WAIT_V(8); PG8_WAIT_L(0); PG8_BAR; PG8_MMA(1, 0, At, B0); PG8_MMA(1, 1, At, B1); PG8_BAR; PG8_SCHED;
            } else {
            PG8_LDB(B0, 0, 0); PG8_SCHED; PG8_LDA(At, 0, 0); PG8_STAGE(PG8_SA(1, 1), a1 + hstep, voffA);
            PG8_WAIT_L(8); PG8_BAR; PG8_WAIT_L(0); PG8_MMA(0, 0, At, B0); PG8_BAR; PG8_SCHED;
            PG8_LDB(B1, 0, 1); PG8_STAGE(PG8_SB(0, 0), b2, voffB);
            PG8_BAR; PG8_WAIT_L(0); PG8_MMA(0, 1, At, B1); PG8_BAR;
            PG8_LDA(At, 0, 1); PG8_STAGE(PG8_SA(0, 0), a2, voffA);
            PG8_BAR; PG8_WAIT_L(0); PG8_MMA(1, 0, At, B0); PG8_BAR; PG8_SCHED;
            PG8_STAGE(PG8_SB(0, 1), b2 + hstep, voffB);
            PG8_WAIT_V(6); PG8_BAR; PG8_MMA(1, 1, At, B1); PG8_BAR;
            PG8_LDB(B0, 1, 0); PG8_SCHED; PG8_LDA(At, 1, 0); PG8_STAGE(PG8_SA(0, 1), a2 + hstep, voffA);
            PG8_WAIT_L(8); PG8_BAR; PG8_WAIT_L(0); PG8_MMA(0, 0, At, B0); PG8_BAR; PG8_SCHED;
            PG8_LDB(B1, 1, 1); PG8_STAGE(PG8_SB(1, 0), b3, voffB);
            PG8_BAR; PG8_WAIT_L(0); PG8_MMA(0, 1, At, B1); PG8_BAR;
            PG8_LDA(At, 1, 1); PG8_STAGE(PG8_SA(1, 0), a3, voffA);
            PG8_BAR; PG8_WAIT_L(0); PG8_MMA(1, 0, At, B0); PG8_BAR; PG8_SCHED;
            PG8_STAGE(PG8_SB(1, 1), b3 + hstep, voffB);
            PG8_WAIT_V(6); PG8_BAR; PG8_MMA(1, 1, At, B1); PG8_BAR;
            }
        }
        if constexpr (ALIGN_EPI) { if (wr == 0) PG8_BAR; }
        if constexpr (!Epi::AFTER_DRAIN) { E(acc, cur, wr, wc, fr, fq); S.done(cur); }
        if (!has_next) break;
#pragma unroll
        for (int a = 0; a < 2; ++a)
#pragma unroll
            for (int b = 0; b < 2; ++b)
#pragma unroll
                for (int m = 0; m < 4; ++m)
#pragma unroll
                    for (int n = 0; n < 2; ++n) acc[a][b][m][n] = (f32x4){0.f, 0.f, 0.f, 0.f};
        cur = nxt; cA = nA; cB = nB; ++ui;
        if constexpr (ALIGN_EPI) { if (wr == 1) PG8_BAR; }
    }
    PG8_WAIT_V(0);
    if constexpr (!ALIGN_EPI) { if (wr == 0) PG8_BAR; }
    PG8_BAR;
    if constexpr (Epi::AFTER_DRAIN) { E.fused(acc, cur, wr, wc, fr, fq, lds, wid, lane); S.done(cur); }
#undef PG8_SA
#undef PG8_SB
#undef PG8_STAGE
#undef PG8_LDA
#undef PG8_LDB
#undef PG8_MMA
#undef PG8_WAIT_V
#undef PG8_WAIT_L
#undef PG8_BAR
#undef PG8_SCHED
}
}
#define LAS __attribute__((address_space(3)))
__device__ __forceinline__ int opaque_tid() { int t = threadIdx.x; asm volatile("" : "+v"(t)); return t; }
using pg8::bf16_t; using pg8::bf16x8; using pg8::f32x4; using pg8::u32x4;
typedef short s16x4 __attribute__((ext_vector_type(4)));
typedef float f32x16 __attribute__((ext_vector_type(16)));
typedef unsigned u32x2 __attribute__((ext_vector_type(2)));
constexpr int M_TOK = 32768, DM = 1024, SEQ = 4096, FFD = 2816;
constexpr size_t KiB = 1024, MiB = 1024 * 1024;
constexpr size_t WS_CSP = 1 * MiB, WS_CSM = 1 * MiB + 256 * KiB;
constexpr size_t WS_W = 2 * MiB, W_LSTRIDE = 35 * MiB;
constexpr size_t W13_OFF0 = 0, W2_OFF0 = 11 * MiB, W13_OFF1 = 16 * MiB + 512 * KiB, W2_OFF1 = 27 * MiB + 512 * KiB, WOUT_OFF = 33 * MiB;
constexpr size_t WS_WDSA = 142 * MiB, WDSA_STRIDE = 7 * MiB + 512 * KiB, WS_WFOX = 157 * MiB, WS_WDQKV = 163 * MiB + 512 * KiB, WS_WUQ = 165 * MiB, WS_WUKV = 166 * MiB + 128 * KiB;
constexpr size_t WS_XB = 168 * MiB, WS_BIG = 232 * MiB, WS_EXT = 424 * MiB;
constexpr int LDS_BYTES = 147456;
constexpr float ALPHA_DN = 1.681792830507429f;

__device__ __forceinline__ float wave_sum(float v) {
#pragma unroll
    for (int o = 1; o < 64; o <<= 1) v += __shfl_xor(v, o);
    return v;
}
#define LDS_WAIT() asm volatile("s_waitcnt lgkmcnt(0)" ::: "memory")

struct Params { const float* in[16]; float* out; unsigned char* ws; int ph_lo, ph_hi; };

__device__ __forceinline__ int srccol(int mode, int n, int Nsrc) {
    if (mode == 0) return n < Nsrc ? n : -1;
    if (mode == 1) { const int t = n >> 8, r = n & 255; return r < 128 ? t * 128 + r : 2816 + t * 128 + (r - 128); }
    if (mode == 2) {
        if (n >= 3656) return -1;
        if (n < 2048 || (n >= 3072 && n < 3648)) { const int j = n & 63; if (j < 16) return (n - j) + ((j & 1) ? 8 + (j >> 1) : (j >> 1)); }
        return n;
    }
    if (mode == 4) {
        if (n < 1024) return (n >> 6) * 96 + (n & 63);
        const int r = n - 1024, h = r >> 5, jj = r & 31; return h * 96 + 64 + ((jj & 1) ? 16 + (jj >> 1) : (jj >> 1));
    }
    if (n < 1024) return (n >> 6) * 128 + (n & 63);
    { const int r = n - 1024; return (r >> 6) * 128 + 64 + (r & 63); }
}
__device__ __forceinline__ void transpose_item(const float* W, int K, int Nsrc, bf16_t* WT, int mode, const float* gain, LAS float* scr, int item, int nblk, int lane) {
    const int kb = item / nblk, nb = item % nblk, k0 = 64 * kb, n0 = 32 * nb;
    const int sc = srccol(mode, n0 + (lane & 31), Nsrc);
#pragma unroll 8
    for (int i = 0; i < 32; ++i) { const int kk = 2 * i + (lane >> 5); float v = 0.f;
        if (sc >= 0) { v = W[(size_t)(k0 + kk) * Nsrc + sc]; if (gain) v *= gain[k0 + kk]; }
        scr[kk * 33 + (lane & 31)] = v; }
    LDS_WAIT(); asm volatile("" ::: "memory");
    const int c = lane & 7;
#pragma unroll
    for (int j = 0; j < 4; ++j) { const int n = (lane >> 3) + 8 * j; const LAS float* s = scr + (8 * c) * 33 + n;
        u32x4 o; o.x = pk_bf16(s[0 * 33], s[1 * 33]); o.y = pk_bf16(s[2 * 33], s[3 * 33]); o.z = pk_bf16(s[4 * 33], s[5 * 33]); o.w = pk_bf16(s[6 * 33], s[7 * 33]);
        *(u32x4*)(WT + (size_t)(n0 + n) * K + k0 + 8 * c) = o; }
    LDS_WAIT(); asm volatile("" ::: "memory");
}
__device__ __forceinline__ void prologue_phase(LAS unsigned char* lds, const Params& p, int G, int bid) {
    const int tid = opaque_tid(), lane = tid & 63, wid = __builtin_amdgcn_readfirstlane(tid >> 6);
    LAS float* scr = (LAS float*)(lds + wid * 8448);
    const int gw = bid * 8 + wid, NGW = G * 8;
    unsigned char* ws = p.ws;
    for (int j = 0; j < 26; ++j) {
        const float* W; const float* gain = nullptr; bf16_t* WT; int K = 1024, Nsrc, Npad, mode = 0;
        if (j < 16) { const int L = j >> 2, w = j & 3; unsigned char* lb = ws + WS_W + (size_t)L * W_LSTRIDE;
            if (w == 0) { W = p.in[1] + (size_t)L * 1024 * 5632; Nsrc = 5632; Npad = 5632; mode = 1; WT = (bf16_t*)(lb + W13_OFF0); }
            else if (w == 1) { W = p.in[2] + (size_t)L * 2816 * 1024; K = 2816; Nsrc = 1024; Npad = 1024; WT = (bf16_t*)(lb + W2_OFF0); }
            else if (w == 2) { W = p.in[3] + (size_t)L * 1024 * 5632; Nsrc = 5632; Npad = 5632; mode = 1; WT = (bf16_t*)(lb + W13_OFF1); }
            else { W = p.in[4] + (size_t)L * 2816 * 1024; K = 2816; Nsrc = 1024; Npad = 1024; WT = (bf16_t*)(lb + W2_OFF1); } }
        else if (j < 20) { const int L = j - 16; W = p.in[7] + (size_t)L * 1024 * 1024; Nsrc = 1024; Npad = 1024; WT = (bf16_t*)(ws + WS_W + (size_t)L * W_LSTRIDE + WOUT_OFF); }
        else if (j < 22) { W = p.in[8] + (size_t)(j - 20) * 1024 * 3656; Nsrc = 3656; Npad = 3840; mode = 2; WT = (bf16_t*)(ws + WS_WDSA + (size_t)(j - 20) * WDSA_STRIDE); }
        else if (j == 22) { W = p.in[9]; Nsrc = 3088; Npad = 3328; WT = (bf16_t*)(ws + WS_WFOX); }
        else if (j == 23) { W = p.in[11]; Nsrc = 672; Npad = 768; WT = (bf16_t*)(ws + WS_WDQKV); }
        else if (j == 24) { W = p.in[13]; K = 384; Nsrc = 1536; Npad = 1536; mode = 4; gain = p.in[12]; WT = (bf16_t*)(ws + WS_WUQ); }
        else { W = p.in[15]; K = 256; Nsrc = 2048; Npad = 2048; mode = 5; gain = p.in[14]; WT = (bf16_t*)(ws + WS_WUKV); }
        const int nblk = Npad / 32, nitems = (K / 64) * nblk;
        for (int it = gw; it < nitems; it += NGW) transpose_item(W, K, Nsrc, WT, mode, gain, scr, it, nblk, lane);
    }
    { const f32x4* x4 = (const f32x4*)p.in[0]; f32x4* o4 = (f32x4*)p.out; u32x2* xb = (u32x2*)(ws + WS_XB);
      const int nth = G * 512;
      for (int i = bid * 512 + tid; i < M_TOK * DM / 4; i += nth) { const f32x4 v = x4[i]; o4[i] = v; u32x2 w; w.x = pk_bf16(v[0], v[1]); w.y = pk_bf16(v[2], v[3]); xb[i] = w; } }
    { float* csp = (float*)(ws + WS_CSP); float* csm = (float*)(ws + WS_CSM); const int nth = G * 512;
      for (int i = bid * 512 + tid; i < 32768 + 65536; i += nth) {
          int t, d; float inv; float* dst;
          if (i < 32768) { t = i >> 3; d = i & 7; inv = powf(500000.0f, -(float)d * 0.125f); dst = csp + (size_t)i * 2; }
          else { const int i2 = i - 32768; t = i2 >> 4; d = i2 & 15; inv = powf(500000.0f, -(float)d * 0.0625f); dst = csm + (size_t)i2 * 2; }
          const float ang = (float)t * inv; dst[0] = cosf(ang); dst[1] = sinf(ang); } }
}

__device__ __forceinline__ void ln_phase(float* X, bf16_t* XB, const float* g, const float* b, int G, int bid) {
    const int tid = opaque_tid(), lane = tid & 63, wid = __builtin_amdgcn_readfirstlane(tid >> 6);
    const int gw = bid * 8 + wid, NGW = G * 8;
    f32x4 gv[4], bv[4];
#pragma unroll
    for (int j = 0; j < 4; ++j) { gv[j] = ((const f32x4*)g)[lane + 64 * j]; bv[j] = ((const f32x4*)b)[lane + 64 * j]; }
    for (int row = gw; row < M_TOK; row += NGW) {
        f32x4* xr = (f32x4*)(X + (size_t)row * DM) + lane;
        f32x4 v[4]; float s = 0.f;
#pragma unroll
        for (int j = 0; j < 4; ++j) { v[j] = xr[64 * j]; s += (v[j][0] + v[j][1]) + (v[j][2] + v[j][3]); }
        const float mean = wave_sum(s) * (1.f / DM); float s2 = 0.f;
#pragma unroll
        for (int j = 0; j < 4; ++j) { v[j] = v[j] - mean; s2 += (v[j][0] * v[j][0] + v[j][1] * v[j][1]) + (v[j][2] * v[j][2] + v[j][3] * v[j][3]); }
        const float rstd = 1.f / sqrtf(wave_sum(s2) * (1.f / DM) + 1e-5f);
        u32x2* o8 = (u32x2*)(XB + (size_t)row * DM) + lane;
#pragma unroll
        for (int j = 0; j < 4; ++j) { const f32x4 y = v[j] * rstd * gv[j] + bv[j]; xr[64 * j] = y; u32x2 w; w.x = pk_bf16(y[0], y[1]); w.y = pk_bf16(y[2], y[3]); o8[64 * j] = w; }
    }
}

__device__ __forceinline__ void fox_scan_phase(LAS unsigned char* lds, const float* LF, float* CUM, int G, int bid) {
    const int tid = opaque_tid(), lane = tid & 63, wid = tid >> 6;
    LAS float* wt = (LAS float*)lds;
    for (int seq = bid; seq < 128; seq += G) {
        const int b = seq >> 4, h = seq & 15;
        float v[8]; float run = 0.f;
#pragma unroll
        for (int e = 0; e < 8; ++e) { run += LF[((size_t)b * SEQ + tid * 8 + e) * 16 + h]; v[e] = run; }
        float x = run;
#pragma unroll
        for (int o = 1; o < 64; o <<= 1) { const float y = __shfl_up(x, o); if (lane >= o) x += y; }
        if (lane == 63) wt[wid] = x;
        __syncthreads();
        float off = x - run;
        for (int w = 0; w < wid; ++w) off += wt[w];
        float* dst = CUM + (size_t)seq * SEQ + tid * 8;
        f32x4 o0 = {v[0] + off, v[1] + off, v[2] + off, v[3] + off}, o1 = {v[4] + off, v[5] + off, v[6] + off, v[7] + off};
        *(f32x4*)dst = o0; *(f32x4*)(dst + 4) = o1;
        __syncthreads();
    }
}

__device__ __forceinline__ void mla_norm_phase(const bf16_t* C, bf16_t* CQN, bf16_t* CKVN, bf16_t* KR, const float* csm, int G, int bid) {
    const int tid = opaque_tid(), lane = tid & 63, wid = __builtin_amdgcn_readfirstlane(tid >> 6);
    const int gw = bid * 8 + wid, NGW = G * 8;
    for (int row = gw; row < M_TOK; row += NGW) {
        const bf16_t* c = C + (size_t)row * 768;
        float q[8]; float s1 = 0.f;
        if (lane < 48) { const u32x4 r = *(const u32x4*)(c + lane * 8);
            q[0] = bf_lo(r.x); q[1] = bf_hi(r.x); q[2] = bf_lo(r.y); q[3] = bf_hi(r.y); q[4] = bf_lo(r.z); q[5] = bf_hi(r.z); q[6] = bf_lo(r.w); q[7] = bf_hi(r.w);
#pragma unroll
            for (int e = 0; e < 8; ++e) s1 += q[e] * q[e]; }
        else {
#pragma unroll
            for (int e = 0; e < 8; ++e) q[e] = 0.f; }
        const float rq = 1.0f / sqrtf(wave_sum(s1) * (1.f / 384.f) + 1e-6f);
        const u32x2 r2 = *(const u32x2*)(c + 384 + lane * 4);
        float k0 = bf_lo(r2.x), k1 = bf_hi(r2.x), k2 = bf_lo(r2.y), k3 = bf_hi(r2.y);
        const float rk = 1.0f / sqrtf(wave_sum(k0 * k0 + k1 * k1 + k2 * k2 + k3 * k3) * (1.f / 256.f) + 1e-6f);
        if (lane < 48) { u32x4 w; w.x = pk_bf16(q[0] * rq, q[1] * rq); w.y = pk_bf16(q[2] * rq, q[3] * rq); w.z = pk_bf16(q[4] * rq, q[5] * rq); w.w = pk_bf16(q[6] * rq, q[7] * rq);
            *(u32x4*)(CQN + (size_t)row * 384 + lane * 8) = w; }
        { u32x2 w; w.x = pk_bf16(k0 * rk, k1 * rk); w.y = pk_bf16(k2 * rk, k3 * rk); *(u32x2*)(CKVN + (size_t)row * 256 + lane * 4) = w; }
        if (lane < 16) { const int t = row & 4095; const float x1 = __uint_as_float((unsigned)c[640 + lane] << 16), x2 = __uint_as_float((unsigned)c[656 + lane] << 16);
            const float cs = csm[((size_t)t * 16 + lane) * 2], sn = csm[((size_t)t * 16 + lane) * 2 + 1];
            *(unsigned*)(KR + (size_t)row * 32 + 2 * lane) = pk_bf16(x1 * cs - x2 * sn, x1 * sn + x2 * cs); }
    }
}

#define MFMA32(a, b, c) __builtin_amdgcn_mfma_f32_32x32x16_bf16((a), (b), (c), 0, 0, 0)
__device__ __forceinline__ void dsa_index_phase(LAS unsigned char* lds, const bf16_t* QI, const bf16_t* KI, const float* WI, unsigned long long* MASK, int G, int bid) {
    LAS unsigned* sc = (LAS unsigned*)lds;
    const int tid = opaque_tid(), lane = tid & 63, wid = __builtin_amdgcn_readfirstlane(tid >> 6), lq = lane & 31, hi = lane >> 5;
    for (int u = bid; u < 4096; u += G) {
        const int b = u >> 9, t0 = (u & 511) * 8; const size_t rowbase = (size_t)b * SEQ;
        if (t0 < 256) {
            const int t = t0 + wid, nb = t + 1 - 64 * lane;
            const unsigned long long word = nb >= 64 ? ~0ull : (nb <= 0 ? 0ull : ((1ull << nb) - 1ull));
            MASK[(rowbase + t) * 64 + lane] = word;
            continue;
        }
        const int nch = (t0 + 8 + 63) >> 6, ntile = 2 * nch;
        bf16x8 qa[2][4];
#pragma unroll
        for (int mt = 0; mt < 2; ++mt)
#pragma unroll
            for (int s = 0; s < 4; ++s) qa[mt][s] = *(const bf16x8*)(QI + (rowbase + t0 + 4 * mt + (lq >> 3)) * 512 + (lq & 7) * 64 + 16 * s + 8 * hi);
        f32x4 w4[8];
#pragma unroll
        for (int tl = 0; tl < 8; ++tl) w4[tl] = *(const f32x4*)(WI + (rowbase + t0 + tl) * 8 + 4 * hi);
        for (int tile = wid; tile < ntile; tile += 8) {
            const int key0 = tile * 32;
            bf16x8 kb[4];
#pragma unroll
            for (int s = 0; s < 4; ++s) kb[s] = *(const bf16x8*)(KI + (rowbase + key0 + lq) * 64 + 16 * s + 8 * hi);
            f32x16 c0, c1;
#pragma unroll
            for (int i = 0; i < 16; ++i) { c0[i] = 0.f; c1[i] = 0.f; }
#pragma unroll
            for (int s = 0; s < 4; ++s) { c0 = MFMA32(qa[0][s], kb[s], c0); c1 = MFMA32(qa[1][s], kb[s], c1); }
            float part[8];
#pragma unroll
            for (int g = 0; g < 4; ++g) {
                part[g] = (w4[g][0] * fmaxf(c0[4 * g], 0.f) + w4[g][1] * fmaxf(c0[4 * g + 1], 0.f)) + (w4[g][2] * fmaxf(c0[4 * g + 2], 0.f) + w4[g][3] * fmaxf(c0[4 * g + 3], 0.f));
                part[4 + g] = (w4[4 + g][0] * fmaxf(c1[4 * g], 0.f) + w4[4 + g][1] * fmaxf(c1[4 * g + 1], 0.f)) + (w4[4 + g][2] * fmaxf(c1[4 * g + 2], 0.f) + w4[4 + g][3] * fmaxf(c1[4 * g + 3], 0.f));
            }
#pragma unroll
            for (int tl = 0; tl < 8; ++tl) part[tl] += __shfl_xor(part[tl], 32);
            const int key = key0 + lq;
#pragma unroll
            for (int k = 0; k < 4; ++k) {
                const int tl = 4 * hi + k; const unsigned hm_ = (unsigned)(-hi); float f = __uint_as_float((__float_as_uint(part[k]) & ~hm_) | (__float_as_uint(part[4 + k]) & hm_));
                f = (f == 0.f) ? 0.f : f;
                const unsigned bits = __float_as_uint(f); unsigned uu = (bits & 0x80000000u) ? ~bits : (bits | 0x80000000u);
                if (key > t0 + tl) uu = 0u;
                sc[tl * 4096 + key] = uu;
            }
        }
        __syncthreads();
        {
            const LAS unsigned* row = sc + wid * 4096; const int t = t0 + wid;
            unsigned T = 0u;
            for (int bit = 31; bit >= 0; --bit) {
                const unsigned cand = T | (1u << bit); int cnt = 0;
#pragma unroll 4
                for (int c = 0; c < nch; ++c) cnt += __popcll(__ballot(row[64 * c + lane] >= cand));
                if (cnt >= 256) T = cand;
            }
            int ngt = 0;
#pragma unroll 4
            for (int c = 0; c < nch; ++c) ngt += __popcll(__ballot(row[64 * c + lane] > T));
            int r = 256 - ngt;
            for (int c = 0; c < 64; ++c) {
                unsigned long long word = 0ull;
                if (c < nch) {
                    const unsigned v = row[64 * c + lane];
                    const unsigned long long gt = __ballot(v > T); unsigned long long eq = __ballot(v == T);
                    const int pe = __popcll(eq); const int take = pe < r ? pe : (r > 0 ? r : 0);
                    for (int drop = pe - take; drop > 0; --drop) eq &= ~(1ull << (63 - __clzll(eq)));
                    r -= take; word = gt | eq;
                }
                if (lane == 0) MASK[(rowbase + t) * 64 + c] = word;
            }
        }
        __syncthreads();
    }
}

struct AttnArgs { const bf16_t* Q; const bf16_t* K; const bf16_t* V; bf16_t* O; const bf16_t* QR; const bf16_t* KR; const float* CUM; const unsigned long long* MASK; };
template <int MODE>
__device__ __forceinline__ void attn_phase(LAS unsigned char* lds, const AttnArgs a, int G, int bid) {
    constexpr int DQK = (MODE == 2) ? 96 : 64, NKS = DQK / 16, KROW = (DQK + 8) * 2, VROW = 144;
    constexpr int KBUF = 64 * KROW, VBUF = 64 * VROW, OFF_K = 0, OFF_V = 2 * KBUF, OFF_C = OFF_V + 2 * VBUF;
    const int tid = opaque_tid(), lane = tid & 63, wid = __builtin_amdgcn_readfirstlane(tid >> 6), lq = lane & 31, hi = lane >> 5;
    const int qq = (lane & 15) >> 2, pp = lane & 3, blk = (lane >> 4) & 1;
    const float NEG = -__builtin_inff();
    for (int ui = bid; ui < 2048; ui += G) {
        const int w = ui & 255, j = ui >> 8, xcd = w & 7, ii = w >> 3, bh = xcd + 8 * (ii >> 1), half = ii & 1, jj = j >> 1;
        const int qb = half == 0 ? ((j & 1) ? 12 - 4 * jj : 15 - 4 * jj) : ((j & 1) ? 13 - 4 * jj : 14 - 4 * jj);
        const int b = bh >> 4, h = bh & 15; const size_t rowbase = (size_t)b * SEQ;
        const int q0 = qb * 256 + wid * 32, qg = q0 + lq, nkt = 4 * qb + 4, ktd = q0 >> 6;
        bf16x8 qf[NKS];
#pragma unroll
        for (int s = 0; s < 4; ++s) qf[s] = *(const bf16x8*)(a.Q + (rowbase + qg) * 1024 + h * 64 + 16 * s + 8 * hi);
        if constexpr (MODE == 2) {
#pragma unroll
            for (int s = 4; s < 6; ++s) qf[s] = *(const bf16x8*)(a.QR + (rowbase + qg) * 512 + h * 32 + 16 * (s - 4) + 8 * hi);
        }
        f32x16 o0, o1;
#pragma unroll
        for (int i = 0; i < 16; ++i) { o0[i] = 0.f; o1[i] = 0.f; }
        float m_run = -1e30f, l_run = 0.f;
        u32x4 rk, rv, rk2 = {0u, 0u, 0u, 0u}; float rc = 0.f;
        unsigned long long mw_cur = 0ull, mw_next = 0ull;
        const int lrow = tid >> 3, lcc = tid & 7;
#define ATT_LOADG(kt_) do { const size_t gr_ = rowbase + 64 * (kt_) + lrow; \
            rk = *(const u32x4*)(a.K + gr_ * 1024 + h * 64 + lcc * 8); rv = *(const u32x4*)(a.V + gr_ * 1024 + h * 64 + lcc * 8); \
            if constexpr (MODE == 2) { if (tid < 256) rk2 = *(const u32x4*)(a.KR + (rowbase + 64 * (kt_) + (tid >> 2)) * 32 + (tid & 3) * 8); } \
            if constexpr (MODE == 1) { if (tid < 64) rc = a.CUM[(size_t)bh * SEQ + 64 * (kt_) + tid]; } } while (0)
#define ATT_STORE(buf_) do { *(LAS u32x4*)(lds + OFF_K + (buf_) * KBUF + lrow * KROW + lcc * 16) = rk; *(LAS u32x4*)(lds + OFF_V + (buf_) * VBUF + lrow * VROW + lcc * 16) = rv; \
            if constexpr (MODE == 2) { if (tid < 256) *(LAS u32x4*)(lds + OFF_K + (buf_) * KBUF + (tid >> 2) * KROW + 128 + (tid & 3) * 16) = rk2; } \
            if constexpr (MODE == 1) { if (tid < 64) *(LAS float*)(lds + OFF_C + (buf_) * 256 + tid * 4) = rc; } } while (0)
        ATT_LOADG(0); ATT_STORE(0);
        if constexpr (MODE == 0) mw_cur = a.MASK[(rowbase + qg) * 64];
        __syncthreads();
        for (int kt = 0; kt < nkt; ++kt) {
            const int buf = kt & 1;
            if (kt + 1 < nkt) ATT_LOADG(kt + 1);
            if constexpr (MODE == 0) { if (kt + 1 <= ktd) mw_next = a.MASK[(rowbase + qg) * 64 + kt + 1]; }
            if (kt <= ktd) {
                const LAS unsigned char* kbp = lds + OFF_K + buf * KBUF; const LAS unsigned char* vbp = lds + OFF_V + buf * VBUF;
                f32x16 s0, s1;
#pragma unroll
                for (int i = 0; i < 16; ++i) { s0[i] = 0.f; s1[i] = 0.f; }
#pragma unroll
                for (int s = 0; s < NKS; ++s) {
                    const bf16x8 a0 = *(const LAS bf16x8*)(kbp + lq * KROW + (16 * s + 8 * hi) * 2);
                    const bf16x8 a1 = *(const LAS bf16x8*)(kbp + (32 + lq) * KROW + (16 * s + 8 * hi) * 2);
                    s0 = MFMA32(a0, qf[s], s0); s1 = MFMA32(a1, qf[s], s1);
                }
                if constexpr (MODE == 1) {
                    const LAS unsigned char* cb = lds + OFF_C + buf * 256;
#pragma unroll
                    for (int g = 0; g < 4; ++g) { const f32x4 ca = *(const LAS f32x4*)(cb + (8 * g + 4 * hi) * 4), cc = *(const LAS f32x4*)(cb + (32 + 8 * g + 4 * hi) * 4);
#pragma unroll
                        for (int e = 0; e < 4; ++e) { s0[4 * g + e] -= ca[e]; s1[4 * g + e] -= cc[e]; } }
                }
                if constexpr (MODE == 0) {
                    const unsigned wl = (unsigned)mw_cur >> (4 * hi), wh = (unsigned)(mw_cur >> 32) >> (4 * hi);
#pragma unroll
                    for (int i = 0; i < 16; ++i) { const int pos = (i & 3) + 8 * (i >> 2); if (!((wl >> pos) & 1u)) s0[i] = NEG; if (!((wh >> pos) & 1u)) s1[i] = NEG; }
                } else {
                    if (kt == ktd) {
                        const int kbase = 64 * kt + 4 * hi;
#pragma unroll
                        for (int i = 0; i < 16; ++i) { const int kl = (i & 3) + 8 * (i >> 2); if (kbase + kl > qg) s0[i] = NEG; if (kbase + 32 + kl > qg) s1[i] = NEG; }
                    }
                }
                float mx = fmaxf(s0[0], s1[0]);
#pragma unroll
                for (int i = 1; i < 16; ++i) mx = fmaxf(mx, fmaxf(s0[i], s1[i]));
                mx = fmaxf(mx, __shfl_xor(mx, 32));
                const float mn = fmaxf(m_run, mx), alpha = __builtin_amdgcn_exp2f(m_run - mn);
                m_run = mn;
                float ls = 0.f;
#pragma unroll
                for (int i = 0; i < 16; ++i) { s0[i] = __builtin_amdgcn_exp2f(s0[i] - mn); s1[i] = __builtin_amdgcn_exp2f(s1[i] - mn); ls += s0[i] + s1[i]; }
                l_run = l_run * alpha + ls;
#pragma unroll
                for (int i = 0; i < 16; ++i) { o0[i] *= alpha; o1[i] *= alpha; }
                bf16x8 pf[4];
#pragma unroll
                for (int s = 0; s < 2; ++s) {
                    u32x4 t0, t1;
                    t0.x = pk_bf16(s0[8 * s], s0[8 * s + 1]); t0.y = pk_bf16(s0[8 * s + 2], s0[8 * s + 3]); t0.z = pk_bf16(s0[8 * s + 4], s0[8 * s + 5]); t0.w = pk_bf16(s0[8 * s + 6], s0[8 * s + 7]);
                    t1.x = pk_bf16(s1[8 * s], s1[8 * s + 1]); t1.y = pk_bf16(s1[8 * s + 2], s1[8 * s + 3]); t1.z = pk_bf16(s1[8 * s + 4], s1[8 * s + 5]); t1.w = pk_bf16(s1[8 * s + 6], s1[8 * s + 7]);
                    pf[s] = __builtin_bit_cast(bf16x8, t0); pf[2 + s] = __builtin_bit_cast(bf16x8, t1);
                }
#pragma unroll
                for (int ks = 0; ks < 4; ++ks) {
#pragma unroll
                    for (int dh = 0; dh < 2; ++dh) {
                        const LAS unsigned char* ap = vbp + (16 * ks + 4 * hi + qq) * VROW + (32 * dh + 16 * blk + 4 * pp) * 2;
                        const s16x4 lo4 = __builtin_amdgcn_ds_read_tr16_b64_v4i16((LAS s16x4*)ap);
                        const s16x4 hi4 = __builtin_amdgcn_ds_read_tr16_b64_v4i16((LAS s16x4*)(ap + 8 * VROW));
                        const bf16x8 av = __builtin_shufflevector(lo4, hi4, 0, 1, 2, 3, 4, 5, 6, 7);
                        if (dh == 0) o0 = MFMA32(av, pf[ks], o0); else o1 = MFMA32(av, pf[ks], o1);
                    }
                }
            }
            if (kt + 1 < nkt) ATT_STORE(buf ^ 1);
            __syncthreads();
            mw_cur = mw_next;
        }
        const float lt = l_run + __shfl_xor(l_run, 32), inv = 1.0f / lt;
        bf16_t* op = a.O + (rowbase + qg) * 1024 + h * 64 + 4 * hi;
#pragma unroll
        for (int g = 0; g < 4; ++g) {
            u32x2 w0, w1;
            w0.x = pk_bf16(o0[4 * g] * inv, o0[4 * g + 1] * inv); w0.y = pk_bf16(o0[4 * g + 2] * inv, o0[4 * g + 3] * inv);
            w1.x = pk_bf16(o1[4 * g] * inv, o1[4 * g + 1] * inv); w1.y = pk_bf16(o1[4 * g + 2] * inv, o1[4 * g + 3] * inv);
            *(u32x2*)(op + 8 * g) = w0; *(u32x2*)(op + 32 + 8 * g) = w1;
        }
#undef ATT_LOADG
#undef ATT_STORE
    }
}
__global__ void __launch_bounds__(512, 2) mega(Params p) {
    extern __shared__ __attribute__((aligned(16))) unsigned char lds_raw[];
    LAS unsigned char* lds = (LAS unsigned char*)lds_raw;
    cg::grid_group grid = cg::this_grid();
    const int G = gridDim.x, bid = blockIdx.x;
    unsigned char* ws = p.ws;
    int ph = 0; const int lo = p.ph_lo, hi = p.ph_hi;
#define RUN() (ph >= lo && ph < hi)
#define SEAM() do { if (ph >= lo && ph + 1 < hi) grid.sync(); ++ph; } while (0)
    bf16_t* XB = (bf16_t*)(ws + WS_XB);
    bf16_t* HB = (bf16_t*)(ws + WS_BIG);
    bf16_t* QO = (bf16_t*)(ws + WS_BIG); bf16_t* KB = (bf16_t*)(ws + WS_BIG + 64 * MiB); bf16_t* VB = (bf16_t*)(ws + WS_BIG + 128 * MiB);
    const float* csp = (const float*)(ws + WS_CSP); const float* csm = (const float*)(ws + WS_CSM);
    bf16_t* QI = (bf16_t*)(ws + WS_EXT); bf16_t* KI = (bf16_t*)(ws + WS_EXT + 32 * MiB); float* WI = (float*)(ws + WS_EXT + 36 * MiB); unsigned long long* MASK = (unsigned long long*)(ws + WS_EXT + 37 * MiB);
    float* LF = (float*)(ws + WS_EXT); float* CUM = (float*)(ws + WS_EXT + 2 * MiB);
    bf16_t* CQN = (bf16_t*)(ws + WS_EXT); bf16_t* CKVN = (bf16_t*)(ws + WS_EXT + 24 * MiB); bf16_t* KR = (bf16_t*)(ws + WS_EXT + 40 * MiB); bf16_t* QR = (bf16_t*)(ws + WS_EXT + 42 * MiB);
    bf16_t* CB = (bf16_t*)(ws + WS_BIG);

    if (RUN()) prologue_phase(lds, p, G, bid);
    SEAM();
    for (int L = 0; L < 4; ++L) {
        const int kind = L % 3, jm = L / 3;
        unsigned char* lw = ws + WS_W + (size_t)L * W_LSTRIDE;
        for (int sub = 0; sub < 3; ++sub) {
            if (sub != 1) {
                if (RUN()) {
                    pg8::Gemm g{XB, (const bf16_t*)(lw + (sub == 0 ? W13_OFF0 : W13_OFF1)), M_TOK, 5632, 1024};
                    pg8::StaticOrder S; S.init(M_TOK, 5632, G, bid);
                    pg8::EpiSwiglu E{HB};
                    pg8::gemm_phase<pg8::EpiSwiglu, pg8::StaticOrder, true, true>(lds, g, S, E);
                }
                SEAM();
            } else {
                if (RUN()) {
                    pg8::EpiProj E{}; E.QO = QO; E.KB = KB; E.VB = VB; E.csp = csp; E.csm = csm; E.wscale = 0.35355339059327373f * 0.125f;
                    const bf16_t* Bt; int N;
                    if (kind == 0) { E.mode = 1; E.X0 = QI; E.KI = KI; E.F0 = WI; E.qscale = 0.125f * LOG2E; Bt = (const bf16_t*)(ws + WS_WDSA + (size_t)jm * WDSA_STRIDE); N = 3840; }
                    else if (kind == 1) { E.mode = 2; E.F0 = LF; E.bfox = p.in[10]; E.qscale = 0.125f * LOG2E; Bt = (const bf16_t*)(ws + WS_WFOX); N = 3328; }
                    else { E.mode = 3; E.X0 = CB; E.qscale = 1.f; Bt = (const bf16_t*)(ws + WS_WDQKV); N = 768; }
                    pg8::Gemm g{XB, Bt, M_TOK, N, 1024};
                    pg8::StaticOrder S; S.init(M_TOK, N, G, bid);
                    pg8::gemm_phase<pg8::EpiProj, pg8::StaticOrder, true, true>(lds, g, S, E);
                }
                SEAM();
                if (kind == 0) {
                    if (RUN()) dsa_index_phase(lds, QI, KI, WI, MASK, G, bid);
                    SEAM();
                    if (RUN()) { AttnArgs a{QO, KB, VB, QO, nullptr, nullptr, nullptr, MASK}; attn_phase<0>(lds, a, G, bid); }
                    SEAM();
                } else if (kind == 1) {
                    if (RUN()) fox_scan_phase(lds, LF, CUM, G, bid);
                    SEAM();
                    if (RUN()) { AttnArgs a{QO, KB, VB, QO, nullptr, nullptr, CUM, nullptr}; attn_phase<1>(lds, a, G, bid); }
                    SEAM();
                } else {
                    if (RUN()) mla_norm_phase(CB, CQN, CKVN, KR, csm, G, bid);
                    SEAM();
                    if (RUN()) {
                        for (int gi = 0; gi < 2; ++gi) {
                            pg8::EpiProj E{}; E.QO = QO; E.KB = KB; E.VB = VB; E.csp = csp; E.csm = csm; E.X0 = QR; E.mode = 4 + gi; E.qscale = 0.10206207261596575f * LOG2E;
                            const int N = gi == 0 ? 1536 : 2048, K = gi == 0 ? 384 : 256;
                            pg8::Gemm g{gi == 0 ? CQN : CKVN, (const bf16_t*)(ws + (gi == 0 ? WS_WUQ : WS_WUKV)), M_TOK, N, K};
                            pg8::StaticOrder S; S.init(M_TOK, N, G, bid);
                            pg8::gemm_phase<pg8::EpiProj, pg8::StaticOrder, true, true>(lds, g, S, E);
                        }
                    }
                    SEAM();
                    if (RUN()) { AttnArgs a{QO, KB, VB, QO, QR, KR, nullptr, nullptr}; attn_phase<2>(lds, a, G, bid); }
                    SEAM();
                }
            }
            if (RUN()) {
                const bf16_t* A = sub != 1 ? HB : QO; const int K = sub != 1 ? FFD : 1024;
                const bf16_t* Bt = (const bf16_t*)(lw + (sub == 0 ? W2_OFF0 : (sub == 2 ? W2_OFF1 : WOUT_OFF)));
                pg8::Gemm g{A, Bt, M_TOK, 1024, K};
                pg8::StaticOrder S; S.init(M_TOK, 1024, G, bid);
                pg8::EpiResid E{p.out, ALPHA_DN, sub != 1 ? 0.5f : 1.0f};
                pg8::gemm_phase<pg8::EpiResid, pg8::StaticOrder, true, true>(lds, g, S, E);
            }
            SEAM();
            if (RUN()) ln_phase(p.out, XB, p.in[5] + (size_t)(L * 3 + sub) * 1024, p.in[6] + (size_t)(L * 3 + sub) * 1024, G, bid);
            SEAM();
        }
    }
}
constexpr int N_PHASES = 46;

extern "C" void kernel_launch(void* const* d_in, const int* in_sizes, int n_in, void* d_out, int out_size, void* d_ws, size_t ws_size, hipStream_t stream) {
    static int grid = 0;
    if (grid == 0) {
        int dev = 0, cus = 0, per_cu = 0;
        hipGetDevice(&dev);
        hipDeviceGetAttribute(&cus, hipDeviceAttributeMultiprocessorCount, dev);
        if (hipFuncSetAttribute((const void*)mega, hipFuncAttributeMaxDynamicSharedMemorySize, LDS_BYTES) != hipSuccess) fprintf(stderr, "kernel_launch: hipFuncSetAttribute failed\n");
        if (hipOccupancyMaxActiveBlocksPerMultiprocessor(&per_cu, (const void*)mega, 512, LDS_BYTES) != hipSuccess || per_cu < 1) { fprintf(stderr, "kernel_launch: occupancy query says %d\n", per_cu); per_cu = 1; }
        (void)hipGetLastError();
        grid = cus * 1;
        if (ws_size < 498 * MiB) fprintf(stderr, "kernel_launch: workspace too small: %zu\n", ws_size);
        if (n_in != 16) fprintf(stderr, "kernel_launch: expected 16 inputs, got %d\n", n_in);
    }
    Params p{};
    for (int i = 0; i < 16; ++i) p.in[i] = (const float*)d_in[i];
    p.out = (float*)d_out; p.ws = (unsigned char*)d_ws;
#if MK_MULTI
    for (int ph = 0; ph < N_PHASES; ++ph) { p.ph_lo = ph; p.ph_hi = ph + 1; hipLaunchKernelGGL(mega, dim3(grid), dim3(512), LDS_BYTES, stream, p); }
#else
    p.ph_lo = 0; p.ph_hi = 1 << 20;
    void* args[] = {&p};
    hipError_t e = hipLaunchCooperativeKernel((const void*)mega, dim3(grid), dim3(512), args, LDS_BYTES, stream);
    if (e != hipSuccess) fprintf(stderr, "cooperative launch failed: %s (grid %d)\n", hipGetErrorString(e), grid);
#endif
}
```

```cpp
#include <hip/hip_runtime.h>
#include <hip/hip_cooperative_groups.h>
#include <cstdio>
#include <cstdint>
namespace cg = cooperative_groups;
#ifndef MK_MULTI
#define MK_MULTI 0
#endif
typedef __bf16 bf2_t __attribute__((ext_vector_type(2)));
typedef float f32x2_t __attribute__((ext_vector_type(2)));
__device__ __forceinline__ unsigned pk_bf16(float lo, float hi) { f32x2_t v = {lo, hi}; return __builtin_bit_cast(unsigned, __builtin_convertvector(v, bf2_t)); }
__device__ __forceinline__ float bf_lo(unsigned w) { return __uint_as_float(w << 16); }
__device__ __forceinline__ float bf_hi(unsigned w) { return __uint_as_float(w & 0xffff0000u); }
#define LOG2E 1.4426950408889634f
namespace pg8 {
#define PG8_LAS __attribute__((address_space(3)))
typedef unsigned short bf16_t;
typedef short bf16x8 __attribute__((ext_vector_type(8)));
typedef float f32x4 __attribute__((ext_vector_type(4)));
typedef unsigned u32x4 __attribute__((ext_vector_type(4)));
constexpr int BM = 256, BK = 64, HALF = 128, HTB = HALF * BK * 2  , STAGE_BYTES = 8 * HTB, NXCD = 8, WGM = 8;

__host__ __device__ __forceinline__ int lds_byte(int r, int c) { const int st = (r >> 4) * 2 + (c >> 5), rr = r & 15, cc = c & 31, ob = rr * 64 + cc * 2; return st * 1024 + (ob ^ (((ob >> 9) & 1) << 5)); }
__host__ __device__ __forceinline__ void stage_rc(int b, int& R, int& C) { const int st = b / 1024, sb = b % 1024, swz = sb ^ (((sb >> 9) & 1) << 5); R = (st >> 1) * 16 + swz / 64; C = (st & 1) * 32 + (swz % 64) / 2; }
__host__ __device__ __forceinline__ int perm32(int rho) { const int n = rho >> 4, i = rho & 15; return 8 * (i >> 2) + 4 * n + (i & 3); }

struct Unit { int pm, pn; };
struct Gemm { const bf16_t* A; const bf16_t* Bt; int M, N, K; };

struct StaticOrder {
    int nM, nN, nwg, G, c;
    __host__ __device__ void init(int M, int N, int G_, int c_) { nM = M / BM; nN = N / BM; nwg = nM * nN; G = G_; c = c_; }
    __host__ __device__ bool next(int i, Unit& u) const {
        const long L = (long)i * G + c; if (L >= nwg) return false;
        int wgid = (int)L; { const int q = nwg / NXCD, r = nwg % NXCD, xcd = wgid % NXCD, off = wgid / NXCD; wgid = (xcd < r ? xcd * (q + 1) : r * (q + 1) + (xcd - r) * q) + off; }
        const int nig = WGM * nN, gid = wgid / nig, fm = gid * WGM, gsz = (nM - fm) < WGM ? (nM - fm) : WGM;
        u.pm = fm + ((wgid % nig) % gsz); u.pn = (wgid % nig) / gsz; return true;
    }
    __device__ __forceinline__ void a_ready(const Unit&) const {}
    __device__ __forceinline__ void done(const Unit&) const {}
};
__device__ __forceinline__ unsigned cvt_pk_bf16(float lo, float hi) { unsigned r; asm volatile("v_cvt_pk_bf16_f32 %0, %1, %2" : "=v"(r) : "v"(lo), "v"(hi)); return r; }
typedef float f32x2 __attribute__((ext_vector_type(2)));
__device__ __forceinline__ float silu_f(float x) { return x * __builtin_amdgcn_rcpf(1.0f + __builtin_amdgcn_exp2f(-x * LOG2E)); }
struct EpiSwiglu {
    static constexpr bool PERM = true, AFTER_DRAIN = false;
    bf16_t* H;
    __device__ __forceinline__ void operator()(const f32x4 (&acc)[2][2][4][2], const Unit& u, int wr, int wc, int fr, int fq) const {
        const int row0 = u.pm * BM + wr * 64 + fr, col0 = u.pn * 128 + wc * 32 + 8 * fq;
#pragma unroll
        for (int ai = 0; ai < 2; ++ai)
#pragma unroll
            for (int m = 0; m < 4; ++m) {
                bf16_t* rowp = H + (size_t)(row0 + ai * HALF + m * 16) * 2816 + col0;
                const f32x4 g0 = acc[ai][0][m][0], g1 = acc[ai][0][m][1], u0 = acc[ai][1][m][0], u1 = acc[ai][1][m][1];
                u32x4 w;
                w.x = pk_bf16(silu_f(g0[0]) * u0[0], silu_f(g0[1]) * u0[1]); w.y = pk_bf16(silu_f(g0[2]) * u0[2], silu_f(g0[3]) * u0[3]);
                w.z = pk_bf16(silu_f(g1[0]) * u1[0], silu_f(g1[1]) * u1[1]); w.w = pk_bf16(silu_f(g1[2]) * u1[2], silu_f(g1[3]) * u1[3]);
                *(u32x4*)rowp = w;
            }
    }
};
struct EpiResid {
    static constexpr bool PERM = false, AFTER_DRAIN = false;
    float* X; float alpha, s;
    __device__ __forceinline__ void operator()(const f32x4 (&acc)[2][2][4][2], const Unit& u, int wr, int wc, int fr, int fq) const {
        const int row0 = u.pm * BM + wr * 64 + fr, col0 = u.pn * BM + wc * 32 + 4 * fq;
#pragma unroll
        for (int ai = 0; ai < 2; ++ai)
#pragma unroll
            for (int m = 0; m < 4; ++m) {
                float* rowp = X + (size_t)(row0 + ai * HALF + m * 16) * 1024 + col0;
#pragma unroll
                for (int bj = 0; bj < 2; ++bj)
#pragma unroll
                    for (int n = 0; n < 2; ++n) { f32x4* p = (f32x4*)(rowp + bj * HALF + n * 16); const f32x4 x = *p; *p = x * alpha + acc[ai][bj][m][n] * s; }
            }
    }
};
struct EpiProj {
    static constexpr bool PERM = true, AFTER_DRAIN = false;
    int mode;
    bf16_t *QO, *KB, *VB, *X0, *KI; float* F0; const float* bfox; const float* csp; const float* csm; float qscale, wscale;
    __device__ __forceinline__ void store(const f32x4 (&acc)[2][2][4][2], bf16_t* dst, int ld, int cb, float sc, int rope, const float* cs, int nbj, int row0, int wc, int fq) const {
        const bool rot = (rope == 2) || (rope == 1 && !(wc & 1) && fq < 2);
        const int nd = (rope == 2) ? 16 : 8;
#pragma unroll
        for (int ai = 0; ai < 2; ++ai)
#pragma unroll
            for (int m = 0; m < 4; ++m) {
                const int row = row0 + ai * HALF + m * 16, t = row & 4095;
                f32x4 c01 = {1.f, 0.f, 1.f, 0.f}, c23 = {1.f, 0.f, 1.f, 0.f};
                if (rot) { const f32x4* tp = (const f32x4*)(cs + ((size_t)t * nd + 4 * fq) * 2); c01 = tp[0]; c23 = tp[1]; }
#pragma unroll
                for (int bj = 0; bj < 2; ++bj) if (bj < nbj) {
                    f32x4 v0 = acc[ai][bj][m][0], v1 = acc[ai][bj][m][1];
                    if (rot) {
                        f32x4 r0, r1;
                        r0[0] = v0[0] * c01[0] - v0[1] * c01[1]; r0[1] = v0[0] * c01[1] + v0[1] * c01[0];
                        r0[2] = v0[2] * c01[2] - v0[3] * c01[3]; r0[3] = v0[2] * c01[3] + v0[3] * c01[2];
                        r1[0] = v1[0] * c23[0] - v1[1] * c23[1]; r1[1] = v1[0] * c23[1] + v1[1] * c23[0];
                        r1[2] = v1[2] * c23[2] - v1[3] * c23[3]; r1[3] = v1[2] * c23[3] + v1[3] * c23[2];
                        v0 = r0; v1 = r1;
                    }
                    v0 = v0 * sc; v1 = v1 * sc;
                    u32x4 w; w.x = pk_bf16(v0[0], v0[1]); w.y = pk_bf16(v0[2], v0[3]); w.z = pk_bf16(v1[0], v1[1]); w.w = pk_bf16(v1[2], v1[3]);
                    *(u32x4*)(dst + (size_t)row * ld + cb + bj * HALF + wc * 32 + 8 * fq) = w;
                }
            }
    }
    __device__ __forceinline__ void operator()(const f32x4 (&acc)[2][2][4][2], const Unit& u, int wr, int wc, int fr, int fq) const {
        const int pn = u.pn, row0 = u.pm * BM + wr * 64 + fr;
        if (mode == 1) {
            if (pn < 4) store(acc, QO, 1024, pn * 256, qscale, 1, csp, 2, row0, wc, fq);
            else if (pn < 8) store(acc, KB, 1024, (pn - 4) * 256, 1.f, 1, csp, 2, row0, wc, fq);
            else if (pn < 12) store(acc, VB, 1024, (pn - 8) * 256, 1.f, 0, csp, 2, row0, wc, fq);
            else if (pn < 14) store(acc, X0, 512, (pn - 12) * 256, 1.f, 1, csp, 2, row0, wc, fq);
            else {
                if (wc < 2) store(acc, KI, 64, 0, 1.f, 1, csp, 1, row0, wc, fq);
                else if (wc == 2 && fq == 0) {
#pragma unroll
                    for (int ai = 0; ai < 2; ++ai)
#pragma unroll
                        for (int m = 0; m < 4; ++m) { float* wp = F0 + (size_t)(row0 + ai * HALF + m * 16) * 8;
                            *(f32x4*)wp = acc[ai][0][m][0] * wscale; *(f32x4*)(wp + 4) = acc[ai][0][m][1] * wscale; }
                }
            }
        } else if (mode == 2) {
            if (pn < 4) store(acc, QO, 1024, pn * 256, qscale, 0, csp, 2, row0, wc, fq);
            else if (pn < 8) store(acc, KB, 1024, (pn - 4) * 256, 1.f, 0, csp, 2, row0, wc, fq);
            else if (pn < 12) store(acc, VB, 1024, (pn - 8) * 256, 1.f, 0, csp, 2, row0, wc, fq);
            else if (wc == 0 && fq < 2) {
                const f32x4 b0 = *(const f32x4*)(bfox + 8 * fq), b1 = *(const f32x4*)(bfox + 8 * fq + 4);
#pragma unroll
                for (int ai = 0; ai < 2; ++ai)
#pragma unroll
                    for (int m = 0; m < 4; ++m) { float* lp = F0 + (size_t)(row0 + ai * HALF + m * 16) * 16 + 8 * fq;
                        const f32x4 z0 = acc[ai][0][m][0] + b0, z1 = acc[ai][0][m][1] + b1; f32x4 o0, o1;
#pragma unroll
                        for (int e = 0; e < 4; ++e) { o0[e] = (fminf(z0[e], 0.f) - log1pf(expf(-fabsf(z0[e])))) * LOG2E; o1[e] = (fminf(z1[e], 0.f) - log1pf(expf(-fabsf(z1[e])))) * LOG2E; }
                        *(f32x4*)lp = o0; *(f32x4*)(lp + 4) = o1; }
            }
        } else if (mode == 3) {
            store(acc, X0, 768, pn * 256, 1.f, 0, csp, 2, row0, wc, fq);
        } else if (mode == 4) {
            if (pn < 4) store(acc, QO, 1024, pn * 256, qscale, 0, csm, 2, row0, wc, fq);
            else store(acc, X0, 512, (pn - 4) * 256, qscale, 2, csm, 2, row0, wc, fq);
        } else {
            if (pn < 4) store(acc, KB, 1024, pn * 256, 1.f, 0, csp, 2, row0, wc, fq);
            else store(acc, VB, 1024, (pn - 4) * 256, 1.f, 0, csp, 2, row0, wc, fq);
        }
    }
};
template <class Epi, class Sched, bool ALIGN_EPI = false, bool SP2 = false>
__device__ __forceinline__ void gemm_phase(PG8_LAS unsigned char* lds, const Gemm g, const Sched& S, const Epi& E) {
    int tid_ = threadIdx.x; asm volatile("" : "+v"(tid_)); const int tid = tid_, wid = __builtin_amdgcn_readfirstlane(tid >> 6), lane = tid & 63, wr = wid >> 2, wc = wid & 3, fr = lane & 15, fq = lane >> 4;
    const int K = g.K, nt = K / BK;
    unsigned voffA[2], voffB[2];
#pragma unroll
    for (int i = 0; i < 2; ++i) { int R, C; stage_rc(tid * 16 + i * 8192, R, C); const int Rb = Epi::PERM ? ((R & ~31) + perm32(R & 31)) : R;
        voffA[i] = (unsigned)(R * K + C) * 2u; voffB[i] = (unsigned)(Rb * K + C) * 2u; }
    const size_t kstep = (size_t)(BK * 2);
    const size_t hstep = (size_t)HALF * K * 2;
    const size_t tstep = 2 * hstep;
    const unsigned ldsw = (unsigned)wid * 1024u;
    const int aoff = lds_byte(wr * 64 + fr, fq * 8), boff = lds_byte(wc * 32 + fr, fq * 8);
#define PG8_SA(b, h) (((b) * 2 + (h)) * HTB)
#define PG8_SB(b, h) ((4 + (b) * 2 + (h)) * HTB)
#define PG8_STAGE(bufoff, gbase, voff) do { _Pragma("unroll") for (int _i = 0; _i < 2; ++_i) \
        __builtin_amdgcn_global_load_lds((const unsigned*)((const char*)(gbase) + (voff)[_i]), (PG8_LAS unsigned*)(lds + (bufoff) + ldsw + _i * 8192), 16, 0, 0); } while (0)
#define PG8_LDA(dst, b, h) do { _Pragma("unroll") for (int m = 0; m < 4; ++m) _Pragma("unroll") for (int k = 0; k < 2; ++k) dst[m][k] = *(const PG8_LAS bf16x8*)(lds + PG8_SA(b, h) + aoff + m * 2048 + k * 1024); } while (0)
#define PG8_LDB(dst, b, h) do { _Pragma("unroll") for (int n = 0; n < 2; ++n) _Pragma("unroll") for (int k = 0; k < 2; ++k) dst[n][k] = *(const PG8_LAS bf16x8*)(lds + PG8_SB(b, h) + boff + n * 2048 + k * 1024); } while (0)
#define PG8_MMA(ai, bj, At, Bt) do { __builtin_amdgcn_s_setprio(1); _Pragma("unroll") for (int m = 0; m < 4; ++m) _Pragma("unroll") for (int n = 0; n < 2; ++n) _Pragma("unroll") for (int k = 0; k < 2; ++k) \
        acc[ai][bj][m][n] = __builtin_amdgcn_mfma_f32_16x16x32_bf16(Bt[n][k], At[m][k], acc[ai][bj][m][n], 0, 0, 0); __builtin_amdgcn_s_setprio(0); } while (0)
#define PG8_WAIT_V(n) asm volatile("s_waitcnt vmcnt(" #n ")" ::: "memory")
#define PG8_WAIT_L(n) asm volatile("s_waitcnt lgkmcnt(" #n ")" ::: "memory")
#define PG8_BAR __builtin_amdgcn_s_barrier()
#define PG8_SCHED __builtin_amdgcn_sched_barrier(0)
    Unit cur, nxt; int ui = 0;
    if (!S.next(0, cur)) return;
    f32x4 acc[2][2][4][2];
#pragma unroll
    for (int a = 0; a < 2; ++a)
#pragma unroll
        for (int b = 0; b < 2; ++b)
#pragma unroll
            for (int m = 0; m < 4; ++m)
#pragma unroll
                for (int n = 0; n < 2; ++n) acc[a][b][m][n] = (f32x4){0.f, 0.f, 0.f, 0.f};
    bf16x8 At[4][2], B0[2][2], B1[2][2];
    const char* cA = (const char*)g.A + (size_t)cur.pm * tstep; const char* cB = (const char*)g.Bt + (size_t)cur.pn * tstep;
    S.a_ready(cur);
    if constexpr (SP2) {
        PG8_STAGE(PG8_SB(0, 0), cB, voffB); PG8_STAGE(PG8_SB(0, 1), cB + hstep, voffB); PG8_STAGE(PG8_SA(0, 0), cA, voffA); PG8_STAGE(PG8_SA(0, 1), cA + hstep, voffA);
        if (wr == 1) PG8_BAR;
        PG8_WAIT_V(2); PG8_BAR;
        PG8_STAGE(PG8_SB(1, 0), cB + kstep, voffB); PG8_STAGE(PG8_SA(1, 0), cA + kstep, voffA); PG8_STAGE(PG8_SB(1, 1), cB + hstep + kstep, voffB);
        PG8_WAIT_V(6); PG8_BAR;
    } else {
        PG8_STAGE(PG8_SB(0, 0), cB, voffB); PG8_STAGE(PG8_SA(0, 0), cA, voffA); PG8_STAGE(PG8_SB(0, 1), cB + hstep, voffB); PG8_STAGE(PG8_SA(0, 1), cA + hstep, voffA);
        if (wr == 1) PG8_BAR;
        PG8_WAIT_V(4); PG8_BAR;
        PG8_STAGE(PG8_SB(1, 0), cB + kstep, voffB); PG8_STAGE(PG8_SA(1, 0), cA + kstep, voffA); PG8_STAGE(PG8_SB(1, 1), cB + hstep + kstep, voffB);
        PG8_WAIT_V(6); PG8_BAR;
    }
    for (;;) {
        const bool has_next = S.next(ui + 1, nxt);
        const char* nA = has_next ? (const char*)g.A + (size_t)nxt.pm * tstep : cA; const char* nB = has_next ? (const char*)g.Bt + (size_t)nxt.pn * tstep : cB;
        for (int t = 0; t < nt; t += 2) {
            const bool last = (t == nt - 2);
            const char* a1 = cA + (size_t)(t + 1) * kstep;
            const char* a2 = last ? nA : cA + (size_t)(t + 2) * kstep; const char* b2 = last ? nB : cB + (size_t)(t + 2) * kstep;
            const char* a3 = a2 + kstep; const char* b3 = b2 + kstep;
            if (last && has_next) S.a_ready(nxt);
            if constexpr (SP2) {
            PG8_LDB(B0, 0, 0); PG8_LDB(B1, 0, 1); PG8_SCHED; PG8_LDA(At, 0, 0); PG8_STAGE(PG8_SA(1, 1), a1 + hstep, voffA);
            PG8_WAIT_V(8); PG8_WAIT_L(0); PG8_BAR; PG8_MMA(0, 0, At, B0); PG8_MMA(0, 1, At, B1); PG8_BAR; PG8_SCHED;
            PG8_LDA(At, 0, 1); PG8_STAGE(PG8_SB(0, 0), b2, voffB); PG8_STAGE(PG8_SB(0, 1), b2 + hstep, voffB); PG8_STAGE(PG8_SA(0, 0), a2, voffA);
            PG8_WAIT_V(8); PG8_WAIT_L(0); PG8_BAR; PG8_MMA(1, 0, At, B0); PG8_MMA(1, 1, At, B1); PG8_BAR; PG8_SCHED;
            PG8_LDB(B0, 1, 0); PG8_LDB(B1, 1, 1); PG8_SCHED; PG8_LDA(At, 1, 0); PG8_STAGE(PG8_SA(0, 1), a2 + hstep, voffA);
            PG8_WAIT_V(8); PG8_WAIT_L(0); PG8_BAR; PG8_MMA(0, 0, At, B0); PG8_MMA(0, 1, At, B1); PG8_BAR; PG8_SCHED;
            PG8_LDA(At, 1, 1); PG8_STAGE(PG8_SB(1, 0), b3, voffB); PG8_STAGE(PG8_SB(1, 1), b3 + hstep, voffB); PG8_STAGE(PG8_SA(1, 0), a3, voffA);
            PG8_WAIT_V(8); PG8_WAIT_L(0); PG8_BAR; PG8_MMA(1, 0, At, B0); PG8_MMA(1, 1, At, B1); PG8_BAR; PG8_SCHED;
            } else {
            PG8_LDB(B0, 0, 0); PG8_SCHED; PG8_LDA(At, 0, 0); PG8_STAGE(PG8_SA(1, 1), a1 + hstep, voffA);
            PG8_WAIT_L(8); PG8_BAR; PG8_WAIT_L(0); PG8_MMA(0, 0, At, B0); PG8_BAR; PG8_SCHED;
            PG8_LDB(B1, 0, 1); PG8_STAGE(PG8_SB(0, 0), b2, voffB);
            PG8_BAR; PG8_WAIT_L(0); PG8_MMA(0, 1, At, B1); PG8_BAR;
            PG8_LDA(At, 0, 1); PG8_STAGE(PG8_SA(0, 0), a2, voffA);
            PG8_BAR; PG8_WAIT_L(0); PG8_MMA(1, 0, At, B0); PG8_BAR; PG8_SCHED;
            PG8_STAGE(PG8_SB(0, 1), b2 + hstep, voffB);
            PG8_WAIT_V(6); PG8_BAR; PG8_MMA(1, 1, At, B1); PG8_BAR;
            PG8_LDB(B0, 1, 0); PG8_SCHED; PG8_LDA(At, 1, 0); PG8_STAGE(PG8_SA(0, 1), a2 + hstep, voffA);
            PG8_WAIT_L(8); PG8_BAR; PG8_WAIT_L(0); PG8_MMA(0, 0, At, B0); PG8_BAR; PG8_SCHED;
            PG8_LDB(B1, 1, 1); PG8_STAGE(PG8_SB(1, 0), b3, voffB);
            PG8_BAR; PG8_WAIT_L(0); PG8_MMA(0, 1, At, B1); PG8_BAR;
            PG8_LDA(At, 1, 1); PG8_STAGE(PG8_SA(1, 0), a3, voffA);
            PG8_BAR; PG8_WAIT_L(0); PG8_MMA(1, 0, At, B0); PG8_BAR; PG8_SCHED;
            PG8_STAGE(PG8_SB(1, 1), b3 + hstep, voffB);
            PG8_WAIT_V(6); PG8_BAR; PG8_MMA(1, 1, At, B1); PG8_BAR;
            }
        }
        if constexpr (ALIGN_EPI) { if (wr == 0) PG8_BAR; }
        if constexpr (!Epi::AFTER_DRAIN) { E(acc, cur, wr, wc, fr, fq); S.done(cur); }
        if (!has_next) break;
#pragma unroll
        for (int a = 0; a < 2; ++a)
#pragma unroll
            for (int b = 0; b < 2; ++b)
#pragma unroll
                for (int m = 0; m < 4; ++m)
#pragma unroll
                    for (int n = 0; n < 2; ++n) acc[a][b][m][n] = (f32x4){0.f, 0.f, 0.f, 0.f};
        cur = nxt; cA = nA; cB = nB; ++ui;
        if constexpr (ALIGN_EPI) { if (wr == 1) PG8_BAR; }
    }
    PG8_WAIT_V(0);
    if constexpr (!ALIGN_EPI) { if (wr == 0) PG8_BAR; }
    PG8_BAR;
    if constexpr (Epi::AFTER_DRAIN) { E.fused(acc, cur, wr, wc, fr, fq, lds, wid, lane); S.done(cur); }
#undef PG8_SA
#undef PG8_SB
#undef PG8_STAGE
#undef PG8_LDA
#undef PG8_LDB
#undef PG8_MMA
#undef PG8_WAIT_V
#undef PG8_WAIT_L
#undef PG8_BAR
#undef PG8_SCHED
}
}
#define LAS __attribute__((address_space(3)))
__device__ __forceinline__ int opaque_tid() { int t = threadIdx.x; asm volatile("" : "+v"(t)); return t; }
using pg8::bf16_t; using pg8::bf16x8; using pg8::f32x4; using pg8::u32x4;
typedef short s16x4 __attribute__((ext_vector_type(4)));
typedef float f32x16 __attribute__((ext_vector_type(16)));
typedef unsigned u32x2 __attribute__((ext_vector_type(2)));
constexpr int M_TOK = 32768, DM = 1024, SEQ = 4096, FFD = 2816;
constexpr size_t KiB = 1024, MiB = 1024 * 1024;
constexpr size_t WS_CSP = 1 * MiB, WS_CSM = 1 * MiB + 256 * KiB;
constexpr size_t WS_W = 2 * MiB, W_LSTRIDE = 35 * MiB;
constexpr size_t W13_OFF0 = 0, W2_OFF0 = 11 * MiB, W13_OFF1 = 16 * MiB + 512 * KiB, W2_OFF1 = 27 * MiB + 512 * KiB, WOUT_OFF = 33 * MiB;
constexpr size_t WS_WDSA = 142 * MiB, WDSA_STRIDE = 7 * MiB + 512 * KiB, WS_WFOX = 157 * MiB, WS_WDQKV = 163 * MiB + 512 * KiB, WS_WUQ = 165 * MiB, WS_WUKV = 166 * MiB + 128 * KiB;
constexpr size_t WS_XB = 168 * MiB, WS_BIG = 232 * MiB, WS_EXT = 424 * MiB;
constexpr int LDS_BYTES = 147456;
constexpr float ALPHA_DN = 1.681792830507429f;

__device__ __forceinline__ float wave_sum(float v) {
#pragma unroll
    for (int o = 1; o < 64; o <<= 1) v += __shfl_xor(v, o);
    return v;
}
#define LDS_WAIT() asm volatile("s_waitcnt lgkmcnt(0)" ::: "memory")

struct Params { const float* in[16]; float* out; unsigned char* ws; int ph_lo, ph_hi; };

__device__ __forceinline__ int srccol(int mode, int n, int Nsrc) {
    if (mode == 0) return n < Nsrc ? n : -1;
    if (mode == 1) { const int t = n >> 8, r = n & 255; return r < 128 ? t * 128 + r : 2816 + t * 128 + (r - 128); }
    if (mode == 2) {
        if (n >= 3656) return -1;
        if (n < 2048 || (n >= 3072 && n < 3648)) { const int j = n & 63; if (j < 16) return (n - j) + ((j & 1) ? 8 + (j >> 1) : (j >> 1)); }
        return n;
    }
    if (mode == 4) {
        if (n < 1024) return (n >> 6) * 96 + (n & 63);
        const int r = n - 1024, h = r >> 5, jj = r & 31; return h * 96 + 64 + ((jj & 1) ? 16 + (jj >> 1) : (jj >> 1));
    }
    if (n < 1024) return (n >> 6) * 128 + (n & 63);
    { const int r = n - 1024; return (r >> 6) * 128 + 64 + (r & 63); }
}
__device__ __forceinline__ void transpose_item(const float* W, int K, int Nsrc, bf16_t* WT, int mode, const float* gain, LAS float* scr, int item, int nblk, int lane) {
    const int kb = item / nblk, nb = item % nblk, k0 = 64 * kb, n0 = 32 * nb;
    const int sc = srccol(mode, n0 + (lane & 31), Nsrc);
#pragma unroll 8
    for (int i = 0; i < 32; ++i) { const int kk = 2 * i + (lane >> 5); float v = 0.f;
        if (sc >= 0) { v = W[(size_t)(k0 + kk) * Nsrc + sc]; if (gain) v *= gain[k0 + kk]; }
        scr[kk * 33 + (lane & 31)] = v; }
    LDS_WAIT(); asm volatile("" ::: "memory");
    const int c = lane & 7;
#pragma unroll
    for (int j = 0; j < 4; ++j) { const int n = (lane >> 3) + 8 * j; const LAS float* s = scr + (8 * c) * 33 + n;
        u32x4 o; o.x = pk_bf16(s[0 * 33], s[1 * 33]); o.y = pk_bf16(s[2 * 33], s[3 * 33]); o.z = pk_bf16(s[4 * 33], s[5 * 33]); o.w = pk_bf16(s[6 * 33], s[7 * 33]);
        *(u32x4*)(WT + (size_t)(n0 + n) * K + k0 + 8 * c) = o; }
    LDS_WAIT(); asm volatile("" ::: "memory");
}
__device__ __forceinline__ void prologue_phase(LAS unsigned char* lds, const Params& p, int G, int bid) {
    const int tid = opaque_tid(), lane = tid & 63, wid = __builtin_amdgcn_readfirstlane(tid >> 6);
    LAS float* scr = (LAS float*)(lds + wid * 8448);
    const int gw = bid * 8 + wid, NGW = G * 8;
    unsigned char* ws = p.ws;
    for (int j = 0; j < 26; ++j) {
        const float* W; const float* gain = nullptr; bf16_t* WT; int K = 1024, Nsrc, Npad, mode = 0;
        if (j < 16) { const int L = j >> 2, w = j & 3; unsigned char* lb = ws + WS_W + (size_t)L * W_LSTRIDE;
            if (w == 0) { W = p.in[1] + (size_t)L * 1024 * 5632; Nsrc = 5632; Npad = 5632; mode = 1; WT = (bf16_t*)(lb + W13_OFF0); }
            else if (w == 1) { W = p.in[2] + (size_t)L * 2816 * 1024; K = 2816; Nsrc = 1024; Npad = 1024; WT = (bf16_t*)(lb + W2_OFF0); }
            else if (w == 2) { W = p.in[3] + (size_t)L * 1024 * 5632; Nsrc = 5632; Npad = 5632; mode = 1; WT = (bf16_t*)(lb + W13_OFF1); }
            else { W = p.in[4] + (size_t)L * 2816 * 1024; K = 2816; Nsrc = 1024; Npad = 1024; WT = (bf16_t*)(lb + W2_OFF1); } }
        else if (j < 20) { const int L = j - 16; W = p.in[7] + (size_t)L * 1024 * 1024; Nsrc = 1024; Npad = 1024; WT = (bf16_t*)(ws + WS_W + (size_t)L * W_LSTRIDE + WOUT_OFF); }
        else if (j < 22) { W = p.in[8] + (size_t)(j - 20) * 1024 * 3656; Nsrc = 3656; Npad = 3840; mode = 2; WT = (bf16_t*)(ws + WS_WDSA + (size_t)(j - 20) * WDSA_STRIDE); }
        else if (j == 22) { W = p.in[9]; Nsrc = 3088; Npad = 3328; WT = (bf16_t*)(ws + WS_WFOX); }
        else if (j == 23) { W = p.in[11]; Nsrc = 672; Npad = 768; WT = (bf16_t*)(ws + WS_WDQKV); }
        else if (j == 24) { W = p.in[13]; K = 384; Nsrc = 1536; Npad = 1536; mode = 4; gain = p.in[12]; WT = (bf16_t*)(ws + WS_WUQ); }
        else { W = p.in[15]; K = 256; Nsrc = 2048; Npad = 2048; mode = 5; gain = p.in[14]; WT = (bf16_t*)(ws + WS_WUKV); }
        const int nblk = Npad / 32, nitems = (K / 64) * nblk;
        for (int it = gw; it < nitems; it += NGW) transpose_item(W, K, Nsrc, WT, mode, gain, scr, it, nblk, lane);
    }
    { const f32x4* x4 = (const f32x4*)p.in[0]; f32x4* o4 = (f32x4*)p.out; u32x2* xb = (u32x2*)(ws + WS_XB);
      const int nth = G * 512;
      for (int i = bid * 512 + tid; i < M_TOK * DM / 4; i += nth) { const f32x4 v = x4[i]; o4[i] = v; u32x2 w; w.x = pk_bf16(v[0], v[1]); w.y = pk_bf16(v[2], v[3]); xb[i] = w; } }
    { float* csp = (float*)(ws + WS_CSP); float* csm = (float*)(ws + WS_CSM); const int nth = G * 512;
      for (int i = bid * 512 + tid; i < 32768 + 65536; i += nth) {
          int t, d; float inv; float* dst;
          if (i < 32768) { t = i >> 3; d = i & 7; inv = powf(500000.0f, -(float)d * 0.125f); dst = csp + (size_t)i * 2; }
          else { const int i2 = i - 32768; t = i2 >> 4; d = i2 & 15; inv = powf(500000.0f, -(float)d * 0.0625f); dst = csm + (size_t)i2 * 2; }
          const float ang = (float)t * inv; dst[0] = cosf(ang); dst[1] = sinf(ang); } }
}

__device__ __forceinline__ void ln_phase(float* X, bf16_t* XB, const float* g, const float* b, int G, int bid) {
    const int tid = opaque_tid(), lane = tid & 63, wid = __builtin_amdgcn_readfirstlane(tid >> 6);
    const int gw = bid * 8 + wid, NGW = G * 8;
    f32x4 gv[4], bv[4];
#pragma unroll
    for (int j = 0; j < 4; ++j) { gv[j] = ((const f32x4*)g)[lane + 64 * j]; bv[j] = ((const f32x4*)b)[lane + 64 * j]; }
    for (int row = gw; row < M_TOK; row += NGW) {
        f32x4* xr = (f32x4*)(X + (size_t)row * DM) + lane;
        f32x4 v[4]; float s = 0.f;
#pragma unroll
        for (int j = 0; j < 4; ++j) { v[j] = xr[64 * j]; s += (v[j][0] + v[j][1]) + (v[j][2] + v[j][3]); }
        const float mean = wave_sum(s) * (1.f / DM); float s2 = 0.f;
#pragma unroll
        for (int j = 0; j < 4; ++j) { v[j] = v[j] - mean; s2 += (v[j][0] * v[j][0] + v[j][1] * v[j][1]) + (v[j][2] * v[j][2] + v[j][3] * v[j][3]); }
        const float rstd = 1.f / sqrtf(wave_sum(s2) * (1.f / DM) + 1e-5f);
        u32x2* o8 = (u32x2*)(XB + (size_t)row * DM) + lane;
#pragma unroll
        for (int j = 0; j < 4; ++j) { const f32x4 y = v[j] * rstd * gv[j] + bv[j]; xr[64 * j] = y; u32x2 w; w.x = pk_bf16(y[0], y[1]); w.y = pk_bf16(y[2], y[3]); o8[64 * j] = w; }
    }
}

__device__ __forceinline__ void fox_scan_phase(LAS unsigned char* lds, const float* LF, float* CUM, int G, int bid) {
    const int tid = opaque_tid(), lane = tid & 63, wid = tid >> 6;
    LAS float* wt = (LAS float*)lds;
    for (int seq = bid; seq < 128; seq += G) {
        const int b = seq >> 4, h = seq & 15;
        float v[8]; float run = 0.f;
#pragma unroll
        for (int e = 0; e < 8; ++e) { run += LF[((size_t)b * SEQ + tid * 8 + e) * 16 + h]; v[e] = run; }
        float x = run;
#pragma unroll
        for (int o = 1; o < 64; o <<= 1) { const float y = __shfl_up(x, o); if (lane >= o) x += y; }
        if (lane == 63) wt[wid] = x;
        __syncthreads();
        float off = x - run;
        for (int w = 0; w < wid; ++w) off += wt[w];
        float* dst = CUM + (size_t)seq * SEQ + tid * 8;
        f32x4 o0 = {v[0] + off, v[1] + off, v[2] + off, v[3] + off}, o1 = {v[4] + off, v[5] + off, v[6] + off, v[7] + off};
        *(f32x4*)dst = o0; *(f32x4*)(dst + 4) = o1;
        __syncthreads();
    }
}

__device__ __forceinline__ void mla_norm_phase(const bf16_t* C, bf16_t* CQN, bf16_t* CKVN, bf16_t* KR, const float* csm, int G, int bid) {
    const int tid = opaque_tid(), lane = tid & 63, wid = __builtin_amdgcn_readfirstlane(tid >> 6);
    const int gw = bid * 8 + wid, NGW = G * 8;
    for (int row = gw; row < M_TOK; row += NGW) {
        const bf16_t* c = C + (size_t)row * 768;
        float q[8]; float s1 = 0.f;
        if (lane < 48) { const u32x4 r = *(const u32x4*)(c + lane * 8);
            q[0] = bf_lo(r.x); q[1] = bf_hi(r.x); q[2] = bf_lo(r.y); q[3] = bf_hi(r.y); q[4] = bf_lo(r.z); q[5] = bf_hi(r.z); q[6] = bf_lo(r.w); q[7] = bf_hi(r.w);
#pragma unroll
            for (int e = 0; e < 8; ++e) s1 += q[e] * q[e]; }
        else {
#pragma unroll
            for (int e = 0; e < 8; ++e) q[e] = 0.f; }
        const float rq = 1.0f / sqrtf(wave_sum(s1) * (1.f / 384.f) + 1e-6f);
        const u32x2 r2 = *(const u32x2*)(c + 384 + lane * 4);
        float k0 = bf_lo(r2.x), k1 = bf_hi(r2.x), k2 = bf_lo(r2.y), k3 = bf_hi(r2.y);
        const float rk = 1.0f / sqrtf(wave_sum(k0 * k0 + k1 * k1 + k2 * k2 + k3 * k3) * (1.f / 256.f) + 1e-6f);
        if (lane < 48) { u32x4 w; w.x = pk_bf16(q[0] * rq, q[1] * rq); w.y = pk_bf16(q[2] * rq, q[3] * rq); w.z = pk_bf16(q[4] * rq, q[5] * rq); w.w = pk_bf16(q[6] * rq, q[7] * rq);
            *(u32x4*)(CQN + (size_t)row * 384 + lane * 8) = w; }
        { u32x2 w; w.x = pk_bf16(k0 * rk, k1 * rk); w.y = pk_bf16(k2 * rk, k3 * rk); *(u32x2*)(CKVN + (size_t)row * 256 + lane * 4) = w; }
        if (lane < 16) { const int t = row & 4095; const float x1 = __uint_as_float((unsigned)c[640 + lane] << 16), x2 = __uint_as_float((unsigned)c[656 + lane] << 16);
            const float cs = csm[((size_t)t * 16 + lane) * 2], sn = csm[((size_t)t * 16 + lane) * 2 + 1];
            *(unsigned*)(KR + (size_t)row * 32 + 2 * lane) = pk_bf16(x1 * cs - x2 * sn, x1 * sn + x2 * cs); }
    }
}

#define MFMA32(a, b, c) __builtin_amdgcn_mfma_f32_32x32x16_bf16((a), (b), (c), 0, 0, 0)
template <int NV>
__device__ __forceinline__ void dsa_select(const LAS unsigned* row, int nch, int lane, unsigned long long* mrow) {
    unsigned v[NV];
#pragma unroll
    for (int c = 0; c < NV; ++c) v[c] = (c < nch) ? row[64 * c + lane] : 0u;
    unsigned T = 0u; bool exact = false;
    for (int bit = 31; bit >= 0; --bit) {
        const unsigned cand = T | (1u << bit); int cnt = 0;
#pragma unroll
        for (int c = 0; c < NV; ++c) { cnt += __popcll(__ballot(v[c] >= cand)); asm volatile("" : "+s"(cnt)); }
        if (cnt >= 256) { T = cand; if (cnt == 256) { exact = true; break; } }
    }
    int r = 1 << 30;
    if (!exact) { int ngt = 0;
#pragma unroll
        for (int c = 0; c < NV; ++c) { ngt += __popcll(__ballot(v[c] > T)); asm volatile("" : "+s"(ngt)); }
        r = 256 - ngt; }
    unsigned long long myword = 0ull;
#pragma unroll
    for (int c = 0; c < NV; ++c) {
        const unsigned long long gt = __ballot(v[c] > T); unsigned long long eq = __ballot(v[c] == T);
        const int pe = __popcll(eq); const int take = pe < r ? pe : (r > 0 ? r : 0);
        for (int drop = pe - take; drop > 0; --drop) eq &= ~(1ull << (63 - __clzll(eq)));
        r -= take; const unsigned long long word = gt | eq;
        if (lane == c) myword = word;
        asm volatile("" : "+s"(r), "+v"(myword));
    }
    mrow[lane] = myword;
}
__device__ __forceinline__ void dsa_index_phase(LAS unsigned char* lds, const bf16_t* QI, const bf16_t* KI, const float* WI, unsigned long long* MASK, int G, int bid) {
    LAS unsigned* sc = (LAS unsigned*)lds;
    const int tid = opaque_tid(), lane = tid & 63, wid = __builtin_amdgcn_readfirstlane(tid >> 6), lq = lane & 31, hi = lane >> 5;
    for (int u = bid; u < 4096; u += G) {
        const int b = u >> 9, t0 = (u & 511) * 8; const size_t rowbase = (size_t)b * SEQ;
        if (t0 < 256) {
            const int t = t0 + wid, nb = t + 1 - 64 * lane;
            const unsigned long long word = nb >= 64 ? ~0ull : (nb <= 0 ? 0ull : ((1ull << nb) - 1ull));
            MASK[(rowbase + t) * 64 + lane] = word;
            continue;
        }
        const int nch = (t0 + 8 + 63) >> 6, ntile = 2 * nch;
        bf16x8 qa[2][4];
#pragma unroll
        for (int mt = 0; mt < 2; ++mt)
#pragma unroll
            for (int s = 0; s < 4; ++s) qa[mt][s] = *(const bf16x8*)(QI + (rowbase + t0 + 4 * mt + (lq >> 3)) * 512 + (lq & 7) * 64 + 16 * s + 8 * hi);
        f32x4 w4[8];
#pragma unroll
        for (int tl = 0; tl < 8; ++tl) w4[tl] = *(const f32x4*)(WI + (rowbase + t0 + tl) * 8 + 4 * hi);
        bf16x8 kn[4];
        const bf16_t* kbase = KI + (rowbase + lq) * 64 + 8 * hi;
#pragma unroll
        for (int s = 0; s < 4; ++s) kn[s] = *(const bf16x8*)(kbase + (size_t)wid * 32 * 64 + 16 * s);
        for (int tile = wid; tile < ntile; tile += 8) {
            const int key0 = tile * 32;
            bf16x8 kb[4];
#pragma unroll
            for (int s = 0; s < 4; ++s) kb[s] = kn[s];
            if (tile + 8 < ntile) {
#pragma unroll
                for (int s = 0; s < 4; ++s) kn[s] = *(const bf16x8*)(kbase + (size_t)(tile + 8) * 32 * 64 + 16 * s);
            }
            f32x16 c0, c1;
#pragma unroll
            for (int i = 0; i < 16; ++i) { c0[i] = 0.f; c1[i] = 0.f; }
#pragma unroll
            for (int s = 0; s < 4; ++s) { c0 = MFMA32(qa[0][s], kb[s], c0); c1 = MFMA32(qa[1][s], kb[s], c1); }
            float part[8];
#pragma unroll
            for (int g = 0; g < 4; ++g) {
                part[g] = (w4[g][0] * fmaxf(c0[4 * g], 0.f) + w4[g][1] * fmaxf(c0[4 * g + 1], 0.f)) + (w4[g][2] * fmaxf(c0[4 * g + 2], 0.f) + w4[g][3] * fmaxf(c0[4 * g + 3], 0.f));
                part[4 + g] = (w4[4 + g][0] * fmaxf(c1[4 * g], 0.f) + w4[4 + g][1] * fmaxf(c1[4 * g + 1], 0.f)) + (w4[4 + g][2] * fmaxf(c1[4 * g + 2], 0.f) + w4[4 + g][3] * fmaxf(c1[4 * g + 3], 0.f));
            }
#pragma unroll
            for (int tl = 0; tl < 8; ++tl) part[tl] += __shfl_xor(part[tl], 32);
            const int key = key0 + lq;
#pragma unroll
            for (int k = 0; k < 4; ++k) {
                const int tl = 4 * hi + k; const unsigned hm_ = (unsigned)(-hi); float f = __uint_as_float((__float_as_uint(part[k]) & ~hm_) | (__float_as_uint(part[4 + k]) & hm_));
                f = (f == 0.f) ? 0.f : f;
                const unsigned bits = __float_as_uint(f); unsigned uu = (bits & 0x80000000u) ? ~bits : (bits | 0x80000000u);
                if (key > t0 + tl) uu = 0u;
                sc[tl * 4096 + key] = uu;
            }
        }
        __syncthreads();
        {
            const LAS unsigned* row = sc + wid * 4096; unsigned long long* mrow = MASK + (rowbase + t0 + wid) * 64;
            if (nch <= 32) dsa_select<32>(row, nch, lane, mrow); else dsa_select<64>(row, nch, lane, mrow);
        }
        __syncthreads();
    }
}

struct AttnArgs { const bf16_t* Q; const bf16_t* K; const bf16_t* V; bf16_t* O; const bf16_t* QR; const bf16_t* KR; const float* CUM; const unsigned long long* MASK; };
template <int MODE>
__device__ __forceinline__ void attn_phase(LAS unsigned char* lds, const AttnArgs a, int G, int bid) {
    constexpr int DQK = (MODE == 2) ? 96 : 64, NKS = DQK / 16, KROW = (DQK + 8) * 2, VROW = 144;
    constexpr int KBUF = 64 * KROW, VBUF = 64 * VROW, OFF_K = 0, OFF_V = 2 * KBUF, OFF_C = OFF_V + 2 * VBUF;
    const int tid = opaque_tid(), lane = tid & 63, wid = __builtin_amdgcn_readfirstlane(tid >> 6), lq = lane & 31, hi = lane >> 5;
    const int qq = (lane & 15) >> 2, pp = lane & 3, blk = (lane >> 4) & 1;
    const float NEG = -__builtin_inff();
    for (int ui = bid; ui < 2048; ui += G) {
        const int w = ui & 255, j = ui >> 8, xcd = w & 7, ii = w >> 3, bh = xcd + 8 * (ii >> 1), half = ii & 1, jj = j >> 1;
        const int qb = half == 0 ? ((j & 1) ? 12 - 4 * jj : 15 - 4 * jj) : ((j & 1) ? 13 - 4 * jj : 14 - 4 * jj);
        const int b = bh >> 4, h = bh & 15; const size_t rowbase = (size_t)b * SEQ;
        const int q0 = qb * 256 + wid * 32, qg = q0 + lq, nkt = 4 * qb + 4, ktd = q0 >> 6;
        bf16x8 qf[NKS];
#pragma unroll
        for (int s = 0; s < 4; ++s) qf[s] = *(const bf16x8*)(a.Q + (rowbase + qg) * 1024 + h * 64 + 16 * s + 8 * hi);
        if constexpr (MODE == 2) {
#pragma unroll
            for (int s = 4; s < 6; ++s) qf[s] = *(const bf16x8*)(a.QR + (rowbase + qg) * 512 + h * 32 + 16 * (s - 4) + 8 * hi);
        }
        f32x16 o0, o1;
#pragma unroll
        for (int i = 0; i < 16; ++i) { o0[i] = 0.f; o1[i] = 0.f; }
        float m_run = -1e30f, l_run = 0.f;
        u32x4 rk, rv, rk2 = {0u, 0u, 0u, 0u}; float rc = 0.f;
        unsigned long long mw_cur = 0ull, mw_next = 0ull;
        const int lrow = tid >> 3, lcc = tid & 7;
#define ATT_LOADG(kt_) do { const size_t gr_ = rowbase + 64 * (kt_) + lrow; \
            rk = *(const u32x4*)(a.K + gr_ * 1024 + h * 64 + lcc * 8); rv = *(const u32x4*)(a.V + gr_ * 1024 + h * 64 + lcc * 8); \
            if constexpr (MODE == 2) { if (tid < 256) rk2 = *(const u32x4*)(a.KR + (rowbase + 64 * (kt_) + (tid >> 2)) * 32 + (tid & 3) * 8); } \
            if constexpr (MODE == 1) { if (tid < 64) rc = a.CUM[(size_t)bh * SEQ + 64 * (kt_) + tid]; } } while (0)
#define ATT_STORE(buf_) do { *(LAS u32x4*)(lds + OFF_K + (buf_) * KBUF + lrow * KROW + lcc * 16) = rk; *(LAS u32x4*)(lds + OFF_V + (buf_) * VBUF + lrow * VROW + lcc * 16) = rv; \
            if constexpr (MODE == 2) { if (tid < 256) *(LAS u32x4*)(lds + OFF_K + (buf_) * KBUF + (tid >> 2) * KROW + 128 + (tid & 3) * 16) = rk2; } \
            if constexpr (MODE == 1) { if (tid < 64) *(LAS float*)(lds + OFF_C + (buf_) * 256 + tid * 4) = rc; } } while (0)
        ATT_LOADG(0); ATT_STORE(0);
        if constexpr (MODE == 0) mw_cur = a.MASK[(rowbase + qg) * 64];
        __syncthreads();
        for (int kt = 0; kt < nkt; ++kt) {
            const int buf = kt & 1;
            if (kt + 1 < nkt) ATT_LOADG(kt + 1);
            if constexpr (MODE == 0) { if (kt + 1 <= ktd) mw_next = a.MASK[(rowbase + qg) * 64 + kt + 1]; }
            if (kt <= ktd) {
                const LAS unsigned char* kbp = lds + OFF_K + buf * KBUF; const LAS unsigned char* vbp = lds + OFF_V + buf * VBUF;
                f32x16 s0, s1;
#pragma unroll
                for (int i = 0; i < 16; ++i) { s0[i] = 0.f; s1[i] = 0.f; }
#pragma unroll
                for (int s = 0; s < NKS; ++s) {
                    const bf16x8 a0 = *(const LAS bf16x8*)(kbp + lq * KROW + (16 * s + 8 * hi) * 2);
                    const bf16x8 a1 = *(const LAS bf16x8*)(kbp + (32 + lq) * KROW + (16 * s + 8 * hi) * 2);
                    s0 = MFMA32(a0, qf[s], s0); s1 = MFMA32(a1, qf[s], s1);
                }
                if constexpr (MODE == 1) {
                    const LAS unsigned char* cb = lds + OFF_C + buf * 256;
#pragma unroll
                    for (int g = 0; g < 4; ++g) { const f32x4 ca = *(const LAS f32x4*)(cb + (8 * g + 4 * hi) * 4), cc = *(const LAS f32x4*)(cb + (32 + 8 * g + 4 * hi) * 4);
#pragma unroll
                        for (int e = 0; e < 4; ++e) { s0[4 * g + e] -= ca[e]; s1[4 * g + e] -= cc[e]; } }
                }
                if constexpr (MODE == 0) {
                    const unsigned wl = (unsigned)mw_cur >> (4 * hi), wh = (unsigned)(mw_cur >> 32) >> (4 * hi);
#pragma unroll
                    for (int i = 0; i < 16; ++i) { const int pos = (i & 3) + 8 * (i >> 2); if (!((wl >> pos) & 1u)) s0[i] = NEG; if (!((wh >> pos) & 1u)) s1[i] = NEG; }
                } else {
                    if (kt == ktd) {
                        const int kbase = 64 * kt + 4 * hi;
#pragma unroll
                        for (int i = 0; i < 16; ++i) { const int kl = (i & 3) + 8 * (i >> 2); if (kbase + kl > qg) s0[i] = NEG; if (kbase + 32 + kl > qg) s1[i] = NEG; }
                    }
                }
                float mx = fmaxf(s0[0], s1[0]);
#pragma unroll
                for (int i = 1; i < 16; ++i) mx = fmaxf(mx, fmaxf(s0[i], s1[i]));
                mx = fmaxf(mx, __shfl_xor(mx, 32));
                const float mn = fmaxf(m_run, mx), alpha = __builtin_amdgcn_exp2f(m_run - mn);
                m_run = mn;
                float ls = 0.f;
#pragma unroll
                for (int i = 0; i < 16; ++i) { s0[i] = __builtin_amdgcn_exp2f(s0[i] - mn); s1[i] = __builtin_amdgcn_exp2f(s1[i] - mn); ls += s0[i] + s1[i]; }
                l_run = l_run * alpha + ls;
#pragma unroll
                for (int i = 0; i < 16; ++i) { o0[i] *= alpha; o1[i] *= alpha; }
                bf16x8 pf[4];
#pragma unroll
                for (int s = 0; s < 2; ++s) {
                    u32x4 t0, t1;
                    t0.x = pk_bf16(s0[8 * s], s0[8 * s + 1]); t0.y = pk_bf16(s0[8 * s + 2], s0[8 * s + 3]); t0.z = pk_bf16(s0[8 * s + 4], s0[8 * s + 5]); t0.w = pk_bf16(s0[8 * s + 6], s0[8 * s + 7]);
                    t1.x = pk_bf16(s1[8 * s], s1[8 * s + 1]); t1.y = pk_bf16(s1[8 * s + 2], s1[8 * s + 3]); t1.z = pk_bf16(s1[8 * s + 4], s1[8 * s + 5]); t1.w = pk_bf16(s1[8 * s + 6], s1[8 * s + 7]);
                    pf[s] = __builtin_bit_cast(bf16x8, t0); pf[2 + s] = __builtin_bit_cast(bf16x8, t1);
                }
#pragma unroll
                for (int ks = 0; ks < 4; ++ks) {
#pragma unroll
                    for (int dh = 0; dh < 2; ++dh) {
                        const LAS unsigned char* ap = vbp + (16 * ks + 4 * hi + qq) * VROW + (32 * dh + 16 * blk + 4 * pp) * 2;
                        const s16x4 lo4 = __builtin_amdgcn_ds_read_tr16_b64_v4i16((LAS s16x4*)ap);
                        const s16x4 hi4 = __builtin_amdgcn_ds_read_tr16_b64_v4i16((LAS s16x4*)(ap + 8 * VROW));
                        const bf16x8 av = __builtin_shufflevector(lo4, hi4, 0, 1, 2, 3, 4, 5, 6, 7);
                        if (dh == 0) o0 = MFMA32(av, pf[ks], o0); else o1 = MFMA32(av, pf[ks], o1);
                    }
                }
            }
            if (kt + 1 < nkt) ATT_STORE(buf ^ 1);
            __syncthreads();
            mw_cur = mw_next;
        }
        const float lt = l_run + __shfl_xor(l_run, 32), inv = 1.0f / lt;
        bf16_t* op = a.O + (rowbase + qg) * 1024 + h * 64 + 4 * hi;
#pragma unroll
        for (int g = 0; g < 4; ++g) {
            u32x2 w0, w1;
            w0.x = pk_bf16(o0[4 * g] * inv, o0[4 * g + 1] * inv); w0.y = pk_bf16(o0[4 * g + 2] * inv, o0[4 * g + 3] * inv);
            w1.x = pk_bf16(o1[4 * g] * inv, o1[4 * g + 1] * inv); w1.y = pk_bf16(o1[4 * g + 2] * inv, o1[4 * g + 3] * inv);
            *(u32x2*)(op + 8 * g) = w0; *(u32x2*)(op + 32 + 8 * g) = w1;
        }
#undef ATT_LOADG
#undef ATT_STORE
    }
}
#ifndef REP_ATTN
#define REP_ATTN 1
#endif
#ifndef REP_IDX
#define REP_IDX 1
#endif
#ifndef REP_G13
#define REP_G13 1
#endif
__global__ void __launch_bounds__(512, 2) mega(Params p) {
    extern __shared__ __attribute__((aligned(16))) unsigned char lds_raw[];
    LAS unsigned char* lds = (LAS unsigned char*)lds_raw;
    cg::grid_group grid = cg::this_grid();
    const int G = gridDim.x, bid = blockIdx.x;
    unsigned char* ws = p.ws;
    int ph = 0; const int lo = p.ph_lo, hi = p.ph_hi;
#define RUN() (ph >= lo && ph < hi)
#define SEAM() do { if (ph >= lo && ph + 1 < hi) grid.sync(); ++ph; } while (0)
    bf16_t* XB = (bf16_t*)(ws + WS_XB);
    bf16_t* HB = (bf16_t*)(ws + WS_BIG);
    bf16_t* QO = (bf16_t*)(ws + WS_BIG); bf16_t* KB = (bf16_t*)(ws + WS_BIG + 64 * MiB); bf16_t* VB = (bf16_t*)(ws + WS_BIG + 128 * MiB);
    const float* csp = (const float*)(ws + WS_CSP); const float* csm = (const float*)(ws + WS_CSM);
    bf16_t* QI = (bf16_t*)(ws + WS_EXT); bf16_t* KI = (bf16_t*)(ws + WS_EXT + 32 * MiB); float* WI = (float*)(ws + WS_EXT + 36 * MiB); unsigned long long* MASK = (unsigned long long*)(ws + WS_EXT + 37 * MiB);
    float* LF = (float*)(ws + WS_EXT); float* CUM = (float*)(ws + WS_EXT + 2 * MiB);
    bf16_t* CQN = (bf16_t*)(ws + WS_EXT); bf16_t* CKVN = (bf16_t*)(ws + WS_EXT + 24 * MiB); bf16_t* KR = (bf16_t*)(ws + WS_EXT + 40 * MiB); bf16_t* QR = (bf16_t*)(ws + WS_EXT + 42 * MiB);
    bf16_t* CB = (bf16_t*)(ws + WS_BIG);

    if (RUN()) prologue_phase(lds, p, G, bid);
    SEAM();
    for (int L = 0; L < 4; ++L) {
        const int kind = L % 3, jm = L / 3;
        unsigned char* lw = ws + WS_W + (size_t)L * W_LSTRIDE;
        for (int sub = 0; sub < 3; ++sub) {
            if (sub != 1) {
                if (RUN()) {
                    pg8::Gemm g{XB, (const bf16_t*)(lw + (sub == 0 ? W13_OFF0 : W13_OFF1)), M_TOK, 5632, 1024};
                    pg8::StaticOrder S; S.init(M_TOK, 5632, G, bid);
                    pg8::EpiSwiglu E{HB};
                    for (int rep = 0; rep < REP_G13; ++rep) pg8::gemm_phase<pg8::EpiSwiglu, pg8::StaticOrder, true, true>(lds, g, S, E);
                }
                SEAM();
            } else {
                if (RUN()) {
                    pg8::EpiProj E{}; E.QO = QO; E.KB = KB; E.VB = VB; E.csp = csp; E.csm = csm; E.wscale = 0.35355339059327373f * 0.125f;
                    const bf16_t* Bt; int N;
                    if (kind == 0) { E.mode = 1; E.X0 = QI; E.KI = KI; E.F0 = WI; E.qscale = 0.125f * LOG2E; Bt = (const bf16_t*)(ws + WS_WDSA + (size_t)jm * WDSA_STRIDE); N = 3840; }
                    else if (kind == 1) { E.mode = 2; E.F0 = LF; E.bfox = p.in[10]; E.qscale = 0.125f * LOG2E; Bt = (const bf16_t*)(ws + WS_WFOX); N = 3328; }
                    else { E.mode = 3; E.X0 = CB; E.qscale = 1.f; Bt = (const bf16_t*)(ws + WS_WDQKV); N = 768; }
                    pg8::Gemm g{XB, Bt, M_TOK, N, 1024};
                    pg8::StaticOrder S; S.init(M_TOK, N, G, bid);
                    pg8::gemm_phase<pg8::EpiProj, pg8::StaticOrder, true, true>(lds, g, S, E);
                }
                SEAM();
                if (kind == 0) {
                    if (RUN()) for (int rep = 0; rep < REP_IDX; ++rep) dsa_index_phase(lds, QI, KI, WI, MASK, G, bid);
                    SEAM();
                    if (RUN()) { AttnArgs a{QO, KB, VB, XB, nullptr, nullptr, nullptr, MASK}; for (int rep = 0; rep < REP_ATTN; ++rep) attn_phase<0>(lds, a, G, bid); }
                    SEAM();
                } else if (kind == 1) {
                    if (RUN()) fox_scan_phase(lds, LF, CUM, G, bid);
                    SEAM();
                    if (RUN()) { AttnArgs a{QO, KB, VB, XB, nullptr, nullptr, CUM, nullptr}; for (int rep = 0; rep < REP_ATTN; ++rep) attn_phase<1>(lds, a, G, bid); }
                    SEAM();
                } else {
                    if (RUN()) mla_norm_phase(CB, CQN, CKVN, KR, csm, G, bid);
                    SEAM();
                    if (RUN()) {
                        for (int gi = 0; gi < 2; ++gi) {
                            pg8::EpiProj E{}; E.QO = QO; E.KB = KB; E.VB = VB; E.csp = csp; E.csm = csm; E.X0 = QR; E.mode = 4 + gi; E.qscale = 0.10206207261596575f * LOG2E;
                            const int N = gi == 0 ? 1536 : 2048, K = gi == 0 ? 384 : 256;
                            pg8::Gemm g{gi == 0 ? CQN : CKVN, (const bf16_t*)(ws + (gi == 0 ? WS_WUQ : WS_WUKV)), M_TOK, N, K};
                            pg8::StaticOrder S; S.init(M_TOK, N, G, bid);
                            pg8::gemm_phase<pg8::EpiProj, pg8::StaticOrder, true, true>(lds, g, S, E);
                        }
                    }
                    SEAM();
                    if (RUN()) { AttnArgs a{QO, KB, VB, XB, QR, KR, nullptr, nullptr}; for (int rep = 0; rep < REP_ATTN; ++rep) attn_phase<2>(lds, a, G, bid); }
                    SEAM();
                }
            }
            if (RUN()) {
                const bf16_t* A = sub != 1 ? HB : XB; const int K = sub != 1 ? FFD : 1024;
                const bf16_t* Bt = (const bf16_t*)(lw + (sub == 0 ? W2_OFF0 : (sub == 2 ? W2_OFF1 : WOUT_OFF)));
                pg8::Gemm g{A, Bt, M_TOK, 1024, K};
                pg8::StaticOrder S; S.init(M_TOK, 1024, G, bid);
                pg8::EpiResid E{p.out, ALPHA_DN, sub != 1 ? 0.5f : 1.0f};
                pg8::gemm_phase<pg8::EpiResid, pg8::StaticOrder, true, true>(lds, g, S, E);
            }
            SEAM();
            if (RUN()) ln_phase(p.out, XB, p.in[5] + (size_t)(L * 3 + sub) * 1024, p.in[6] + (size_t)(L * 3 + sub) * 1024, G, bid);
            SEAM();
        }
    }
}
constexpr int N_PHASES = 46;

extern "C" void kernel_launch(void* const* d_in, const int* in_sizes, int n_in, void* d_out, int out_size, void* d_ws, size_t ws_size, hipStream_t stream) {
    static int grid = 0;
    if (grid == 0) {
        int dev = 0, cus = 0, per_cu = 0;
        hipGetDevice(&dev);
        hipDeviceGetAttribute(&cus, hipDeviceAttributeMultiprocessorCount, dev);
        if (hipFuncSetAttribute((const void*)mega, hipFuncAttributeMaxDynamicSharedMemorySize, LDS_BYTES) != hipSuccess) fprintf(stderr, "kernel_launch: hipFuncSetAttribute failed\n");
        if (hipOccupancyMaxActiveBlocksPerMultiprocessor(&per_cu, (const void*)mega, 512, LDS_BYTES) != hipSuccess || per_cu < 1) { fprintf(stderr, "kernel_launch: occupancy query says %d\n", per_cu); per_cu = 1; }
        (void)hipGetLastError();
        grid = cus * 1;
        if (ws_size < 498 * MiB) fprintf(stderr, "kernel_launch: workspace too small: %zu\n", ws_size);
        if (n_in != 16) fprintf(stderr, "kernel_launch: expected 16 inputs, got %d\n", n_in);
    }
    Params p{};
    for (int i = 0; i < 16; ++i) p.in[i] = (const float*)d_in[i];
    p.out = (float*)d_out; p.ws = (unsigned char*)d_ws;
#if MK_MULTI
    for (int ph = 0; ph < N_PHASES; ++ph) { p.ph_lo = ph; p.ph_hi = ph + 1; hipLaunchKernelGGL(mega, dim3(grid), dim3(512), LDS_BYTES, stream, p); }
#else
    p.ph_lo = 0; p.ph_hi = 1 << 20;
    void* args[] = {&p};
    hipError_t e = hipLaunchCooperativeKernel((const void*)mega, dim3(grid), dim3(512), args, LDS_BYTES, stream);
    if (e != hipSuccess) fprintf(stderr, "cooperative launch failed: %s (grid %d)\n", hipGetErrorString(e), grid);
#endif
}
```

```cpp
#include <hip/hip_runtime.h>
#include <hip/hip_cooperative_groups.h>
#include <cstdio>
#include <cstdint>
namespace cg = cooperative_groups;
#ifndef MK_MULTI
#define MK_MULTI 0
#endif
typedef __bf16 bf2_t __attribute__((ext_vector_type(2)));
typedef float f32x2_t __attribute__((ext_vector_type(2)));
__device__ __forceinline__ unsigned pk_bf16(float lo, float hi) { f32x2_t v = {lo, hi}; return __builtin_bit_cast(unsigned, __builtin_convertvector(v, bf2_t)); }
__device__ __forceinline__ float bf_lo(unsigned w) { return __uint_as_float(w << 16); }
__device__ __forceinline__ float bf_hi(unsigned w) { return __uint_as_float(w & 0xffff0000u); }
#define LOG2E 1.4426950408889634f
namespace pg8 {
#define PG8_LAS __attribute__((address_space(3)))
typedef unsigned short bf16_t;
typedef short bf16x8 __attribute__((ext_vector_type(8)));
typedef float f32x4 __attribute__((ext_vector_type(4)));
typedef unsigned u32x4 __attribute__((ext_vector_type(4)));
constexpr int BM = 256, BK = 64, HALF = 128, HTB = HALF * BK * 2  , STAGE_BYTES = 8 * HTB, NXCD = 8, WGM = 8;

__host__ __device__ __forceinline__ int lds_byte(int r, int c) { const int st = (r >> 4) * 2 + (c >> 5), rr = r & 15, cc = c & 31, ob = rr * 64 + cc * 2; return st * 1024 + (ob ^ (((ob >> 9) & 1) << 5)); }
__host__ __device__ __forceinline__ void stage_rc(int b, int& R, int& C) { const int st = b / 1024, sb = b % 1024, swz = sb ^ (((sb >> 9) & 1) << 5); R = (st >> 1) * 16 + swz / 64; C = (st & 1) * 32 + (swz % 64) / 2; }
__host__ __device__ __forceinline__ int perm32(int rho) { const int n = rho >> 4, i = rho & 15; return 8 * (i >> 2) + 4 * n + (i & 3); }

struct Unit { int pm, pn; };
struct Gemm { const bf16_t* A; const bf16_t* Bt; int M, N, K; };

struct StaticOrder {
    int nM, nN, nwg, G, c;
    __host__ __device__ void init(int M, int N, int G_, int c_) { nM = M / BM; nN = N / BM; nwg = nM * nN; G = G_; c = c_; }
    __host__ __device__ bool next(int i, Unit& u) const {
        const long L = (long)i * G + c; if (L >= nwg) return false;
        int wgid = (int)L; { const int q = nwg / NXCD, r = nwg % NXCD, xcd = wgid % NXCD, off = wgid / NXCD; wgid = (xcd < r ? xcd * (q + 1) : r * (q + 1) + (xcd - r) * q) + off; }
        const int nig = WGM * nN, gid = wgid / nig, fm = gid * WGM, gsz = (nM - fm) < WGM ? (nM - fm) : WGM;
        u.pm = fm + ((wgid % nig) % gsz); u.pn = (wgid % nig) / gsz; return true;
    }
    __device__ __forceinline__ void a_ready(const Unit&) const {}
    __device__ __forceinline__ void done(const Unit&) const {}
};
__device__ __forceinline__ unsigned cvt_pk_bf16(float lo, float hi) { unsigned r; asm volatile("v_cvt_pk_bf16_f32 %0, %1, %2" : "=v"(r) : "v"(lo), "v"(hi)); return r; }
typedef float f32x2 __attribute__((ext_vector_type(2)));
__device__ __forceinline__ float silu_f(float x) { return x * __builtin_amdgcn_rcpf(1.0f + __builtin_amdgcn_exp2f(-x * LOG2E)); }
struct EpiSwiglu {
    static constexpr bool PERM = true, AFTER_DRAIN = false;
    bf16_t* H;
    __device__ __forceinline__ void operator()(const f32x4 (&acc)[2][2][4][2], const Unit& u, int wr, int wc, int fr, int fq) const {
        const int row0 = u.pm * BM + wr * 64 + fr, col0 = u.pn * 128 + wc * 32 + 8 * fq;
#pragma unroll
        for (int ai = 0; ai < 2; ++ai)
#pragma unroll
            for (int m = 0; m < 4; ++m) {
                bf16_t* rowp = H + (size_t)(row0 + ai * HALF + m * 16) * 2816 + col0;
                const f32x4 g0 = acc[ai][0][m][0], g1 = acc[ai][0][m][1], u0 = acc[ai][1][m][0], u1 = acc[ai][1][m][1];
                u32x4 w;
                w.x = pk_bf16(silu_f(g0[0]) * u0[0], silu_f(g0[1]) * u0[1]); w.y = pk_bf16(silu_f(g0[2]) * u0[2], silu_f(g0[3]) * u0[3]);
                w.z = pk_bf16(silu_f(g1[0]) * u1[0], silu_f(g1[1]) * u1[1]); w.w = pk_bf16(silu_f(g1[2]) * u1[2], silu_f(g1[3]) * u1[3]);
                *(u32x4*)rowp = w;
            }
    }
};
struct EpiResid {
    static constexpr bool PERM = false, AFTER_DRAIN = false;
    float* X; float alpha, s;
    __device__ __forceinline__ void operator()(const f32x4 (&acc)[2][2][4][2], const Unit& u, int wr, int wc, int fr, int fq) const {
        const int row0 = u.pm * BM + wr * 64 + fr, col0 = u.pn * BM + wc * 32 + 4 * fq;
#pragma unroll
        for (int ai = 0; ai < 2; ++ai)
#pragma unroll
            for (int m = 0; m < 4; ++m) {
                float* rowp = X + (size_t)(row0 + ai * HALF + m * 16) * 1024 + col0;
#pragma unroll
                for (int bj = 0; bj < 2; ++bj)
#pragma unroll
                    for (int n = 0; n < 2; ++n) { f32x4* p = (f32x4*)(rowp + bj * HALF + n * 16); const f32x4 x = *p; *p = x * alpha + acc[ai][bj][m][n] * s; }
            }
    }
};
struct EpiProj {
    static constexpr bool PERM = true, AFTER_DRAIN = false;
    int mode;
    bf16_t *QO, *KB, *VB, *X0, *KI; float* F0; const float* bfox; const float* csp; const float* csm; float qscale, wscale;
    __device__ __forceinline__ void store(const f32x4 (&acc)[2][2][4][2], bf16_t* dst, int ld, int cb, float sc, int rope, const float* cs, int nbj, int row0, int wc, int fq) const {
        const bool rot = (rope == 2) || (rope == 1 && !(wc & 1) && fq < 2);
        const int nd = (rope == 2) ? 16 : 8;
#pragma unroll
        for (int ai = 0; ai < 2; ++ai)
#pragma unroll
            for (int m = 0; m < 4; ++m) {
                const int row = row0 + ai * HALF + m * 16, t = row & 4095;
                f32x4 c01 = {1.f, 0.f, 1.f, 0.f}, c23 = {1.f, 0.f, 1.f, 0.f};
                if (rot) { const f32x4* tp = (const f32x4*)(cs + ((size_t)t * nd + 4 * fq) * 2); c01 = tp[0]; c23 = tp[1]; }
#pragma unroll
                for (int bj = 0; bj < 2; ++bj) if (bj < nbj) {
                    f32x4 v0 = acc[ai][bj][m][0], v1 = acc[ai][bj][m][1];
                    if (rot) {
                        f32x4 r0, r1;
                        r0[0] = v0[0] * c01[0] - v0[1] * c01[1]; r0[1] = v0[0] * c01[1] + v0[1] * c01[0];
                        r0[2] = v0[2] * c01[2] - v0[3] * c01[3]; r0[3] = v0[2] * c01[3] + v0[3] * c01[2];
                        r1[0] = v1[0] * c23[0] - v1[1] * c23[1]; r1[1] = v1[0] * c23[1] + v1[1] * c23[0];
                        r1[2] = v1[2] * c23[2] - v1[3] * c23[3]; r1[3] = v1[2] * c23[3] + v1[3] * c23[2];
                        v0 = r0; v1 = r1;
                    }
                    v0 = v0 * sc; v1 = v1 * sc;
                    u32x4 w; w.x = pk_bf16(v0[0], v0[1]); w.y = pk_bf16(v0[2], v0[3]); w.z = pk_bf16(v1[0], v1[1]); w.w = pk_bf16(v1[2], v1[3]);
                    *(u32x4*)(dst + (size_t)row * ld + cb + bj * HALF + wc * 32 + 8 * fq) = w;
                }
            }
    }
    __device__ __forceinline__ void operator()(const f32x4 (&acc)[2][2][4][2], const Unit& u, int wr, int wc, int fr, int fq) const {
        const int pn = u.pn, row0 = u.pm * BM + wr * 64 + fr;
        if (mode == 1) {
            if (pn < 4) store(acc, QO, 1024, pn * 256, qscale, 1, csp, 2, row0, wc, fq);
            else if (pn < 8) store(acc, KB, 1024, (pn - 4) * 256, 1.f, 1, csp, 2, row0, wc, fq);
            else if (pn < 12) store(acc, VB, 1024, (pn - 8) * 256, 1.f, 0, csp, 2, row0, wc, fq);
            else if (pn < 14) store(acc, X0, 512, (pn - 12) * 256, 1.f, 1, csp, 2, row0, wc, fq);
            else {
                if (wc < 2) store(acc, KI, 64, 0, 1.f, 1, csp, 1, row0, wc, fq);
                else if (wc == 2 && fq == 0) {
#pragma unroll
                    for (int ai = 0; ai < 2; ++ai)
#pragma unroll
                        for (int m = 0; m < 4; ++m) { float* wp = F0 + (size_t)(row0 + ai * HALF + m * 16) * 8;
                            *(f32x4*)wp = acc[ai][0][m][0] * wscale; *(f32x4*)(wp + 4) = acc[ai][0][m][1] * wscale; }
                }
            }
        } else if (mode == 2) {
            if (pn < 4) store(acc, QO, 1024, pn * 256, qscale, 0, csp, 2, row0, wc, fq);
            else if (pn < 8) store(acc, KB, 1024, (pn - 4) * 256, 1.f, 0, csp, 2, row0, wc, fq);
            else if (pn < 12) store(acc, VB, 1024, (pn - 8) * 256, 1.f, 0, csp, 2, row0, wc, fq);
            else if (wc == 0 && fq < 2) {
                const f32x4 b0 = *(const f32x4*)(bfox + 8 * fq), b1 = *(const f32x4*)(bfox + 8 * fq + 4);
#pragma unroll
                for (int ai = 0; ai < 2; ++ai)
#pragma unroll
                    for (int m = 0; m < 4; ++m) { float* lp = F0 + (size_t)(row0 + ai * HALF + m * 16) * 16 + 8 * fq;
                        const f32x4 z0 = acc[ai][0][m][0] + b0, z1 = acc[ai][0][m][1] + b1; f32x4 o0, o1;
#pragma unroll
                        for (int e = 0; e < 4; ++e) { o0[e] = (fminf(z0[e], 0.f) - log1pf(expf(-fabsf(z0[e])))) * LOG2E; o1[e] = (fminf(z1[e], 0.f) - log1pf(expf(-fabsf(z1[e])))) * LOG2E; }
                        *(f32x4*)lp = o0; *(f32x4*)(lp + 4) = o1; }
            }
        } else if (mode == 3) {
            store(acc, X0, 768, pn * 256, 1.f, 0, csp, 2, row0, wc, fq);
        } else if (mode == 4) {
            if (pn < 4) store(acc, QO, 1024, pn * 256, qscale, 0, csm, 2, row0, wc, fq);
            else store(acc, X0, 512, (pn - 4) * 256, qscale, 2, csm, 2, row0, wc, fq);
        } else {
            if (pn < 4) store(acc, KB, 1024, pn * 256, 1.f, 0, csp, 2, row0, wc, fq);
            else store(acc, VB, 1024, (pn - 4) * 256, 1.f, 0, csp, 2, row0, wc, fq);
        }
    }
};
template <class Epi, class Sched, bool ALIGN_EPI = false, bool SP2 = false>
__device__ __forceinline__ void gemm_phase(PG8_LAS unsigned char* lds, const Gemm g, const Sched& S, const Epi& E) {
    int tid_ = threadIdx.x; asm volatile("" : "+v"(tid_)); const int tid = tid_, wid = __builtin_amdgcn_readfirstlane(tid >> 6), lane = tid & 63, wr = wid >> 2, wc = wid & 3, fr = lane & 15, fq = lane >> 4;
    const int K = g.K, nt = K / BK;
    unsigned voffA[2], voffB[2];
#pragma unroll
    for (int i = 0; i < 2; ++i) { int R, C; stage_rc(tid * 16 + i * 8192, R, C); const int Rb = Epi::PERM ? ((R & ~31) + perm32(R & 31)) : R;
        voffA[i] = (unsigned)(R * K + C) * 2u; voffB[i] = (unsigned)(Rb * K + C) * 2u; }
    const size_t kstep = (size_t)(BK * 2);
    const size_t hstep = (size_t)HALF * K * 2;
    const size_t tstep = 2 * hstep;
    const unsigned ldsw = (unsigned)wid * 1024u;
    const int aoff = lds_byte(wr * 64 + fr, fq * 8), boff = lds_byte(wc * 32 + fr, fq * 8);
#define PG8_SA(b, h) (((b) * 2 + (h)) * HTB)
#define PG8_SB(b, h) ((4 + (b) * 2 + (h)) * HTB)
#define PG8_STAGE(bufoff, gbase, voff) do { _Pragma("unroll") for (int _i = 0; _i < 2; ++_i) \
        __builtin_amdgcn_global_load_lds((const unsigned*)((const char*)(gbase) + (voff)[_i]), (PG8_LAS unsigned*)(lds + (bufoff) + ldsw + _i * 8192), 16, 0, 0); } while (0)
#define PG8_LDA(dst, b, h) do { _Pragma("unroll") for (int m = 0; m < 4; ++m) _Pragma("unroll") for (int k = 0; k < 2; ++k) dst[m][k] = *(const PG8_LAS bf16x8*)(lds + PG8_SA(b, h) + aoff + m * 2048 + k * 1024); } while (0)
#define PG8_LDB(dst, b, h) do { _Pragma("unroll") for (int n = 0; n < 2; ++n) _Pragma("unroll") for (int k = 0; k < 2; ++k) dst[n][k] = *(const PG8_LAS bf16x8*)(lds + PG8_SB(b, h) + boff + n * 2048 + k * 1024); } while (0)
#define PG8_MMA(ai, bj, At, Bt) do { __builtin_amdgcn_s_setprio(1); _Pragma("unroll") for (int m = 0; m < 4; ++m) _Pragma("unroll") for (int n = 0; n < 2; ++n) _Pragma("unroll") for (int k = 0; k < 2; ++k) \
        acc[ai][bj][m][n] = __builtin_amdgcn_mfma_f32_16x16x32_bf16(Bt[n][k], At[m][k], acc[ai][bj][m][n], 0, 0, 0); __builtin_amdgcn_s_setprio(0); } while (0)
#define PG8_WAIT_V(n) asm volatile("s_waitcnt vmcnt(" #n ")" ::: "memory")
#define PG8_WAIT_L(n) asm volatile("s_waitcnt lgkmcnt(" #n ")" ::: "memory")
#define PG8_BAR __builtin_amdgcn_s_barrier()
#define PG8_SCHED __builtin_amdgcn_sched_barrier(0)
    Unit cur, nxt; int ui = 0;
    if (!S.next(0, cur)) return;
    f32x4 acc[2][2][4][2];
#pragma unroll
    for (int a = 0; a < 2; ++a)
#pragma unroll
        for (int b = 0; b < 2; ++b)
#pragma unroll
            for (int m = 0; m < 4; ++m)
#pragma unroll
                for (int n = 0; n < 2; ++n) acc[a][b][m][n] = (f32x4){0.f, 0.f, 0.f, 0.f};
    bf16x8 At[4][2], B0[2][2], B1[2][2];
    const char* cA = (const char*)g.A + (size_t)cur.pm * tstep; const char* cB = (const char*)g.Bt + (size_t)cur.pn * tstep;
    S.a_ready(cur);
    if constexpr (SP2) {
        PG8_STAGE(PG8_SB(0, 0), cB, voffB); PG8_STAGE(PG8_SB(0, 1), cB + hstep, voffB); PG8_STAGE(PG8_SA(0, 0), cA, voffA); PG8_STAGE(PG8_SA(0, 1), cA + hstep, voffA);
        if (wr == 1) PG8_BAR;
        PG8_WAIT_V(2); PG8_BAR;
        PG8_STAGE(PG8_SB(1, 0), cB + kstep, voffB); PG8_STAGE(PG8_SA(1, 0), cA + kstep, voffA); PG8_STAGE(PG8_SB(1, 1), cB + hstep + kstep, voffB);
        PG8_WAIT_V(6); PG8_BAR;
    } else {
        PG8_STAGE(PG8_SB(0, 0), cB, voffB); PG8_STAGE(PG8_SA(0, 0), cA, voffA); PG8_STAGE(PG8_SB(0, 1), cB + hstep, voffB); PG8_STAGE(PG8_SA(0, 1), cA + hstep, voffA);
        if (wr == 1) PG8_BAR;
        PG8_WAIT_V(4); PG8_BAR;
        PG8_STAGE(PG8_SB(1, 0), cB + kstep, voffB); PG8_STAGE(PG8_SA(1, 0), cA + kstep, voffA); PG8_STAGE(PG8_SB(1, 1), cB + hstep + kstep, voffB);
        PG8_WAIT_V(6); PG8_BAR;
    }
    for (;;) {
        const bool has_next = S.next(ui + 1, nxt);
        const char* nA = has_next ? (const char*)g.A + (size_t)nxt.pm * tstep : cA; const char* nB = has_next ? (const char*)g.Bt + (size_t)nxt.pn * tstep : cB;
        for (int t = 0; t < nt; t += 2) {
            const bool last = (t == nt - 2);
            const char* a1 = cA + (size_t)(t + 1) * kstep;
            const char* a2 = last ? nA : cA + (size_t)(t + 2) * kstep; const char* b2 = last ? nB : cB + (size_t)(t + 2) * kstep;
            const char* a3 = a2 + kstep; const char* b3 = b2 + kstep;
            if (last && has_next) S.a_ready(nxt);
            if constexpr (SP2) {
            PG8_LDB(B0, 0, 0); PG8_LDB(B1, 0, 1); PG8_SCHED; PG8_LDA(At, 0, 0); PG8_STAGE(PG8_SA(1, 1), a1 + hstep, voffA);
            PG8_WAIT_V(8); PG8_WAIT_L(0); PG8_BAR; PG8_MMA(0, 0, At, B0); PG8_MMA(0, 1, At, B1); PG8_BAR; PG8_SCHED;
            PG8_LDA(At, 0, 1); PG8_STAGE(PG8_SB(0, 0), b2, voffB); PG8_STAGE(PG8_SB(0, 1), b2 + hstep, voffB); PG8_STAGE(PG8_SA(0, 0), a2, voffA);
            PG8_WAIT_V(8); PG8_WAIT_L(0); PG8_BAR; PG8_MMA(1, 0, At, B0); PG8_MMA(1, 1, At, B1); PG8_BAR; PG8_SCHED;
            PG8_LDB(B0, 1, 0); PG8_LDB(B1, 1, 1); PG8_SCHED; PG8_LDA(At, 1, 0); PG8_STAGE(PG8_SA(0, 1), a2 + hstep, voffA);
            PG8_WAIT_V(8); PG8_WAIT_L(0); PG8_BAR; PG8_MMA(0, 0, At, B0); PG8_MMA(0, 1, At, B1); PG8_BAR; PG8_SCHED;
            PG8_LDA(At, 1, 1); PG8_STAGE(PG8_SB(1, 0), b3, voffB); PG8_STAGE(PG8_SB(1, 1), b3 + hstep, voffB); PG8_STAGE(PG8_SA(1, 0), a3, voffA);
            PG8_WAIT_V(8); PG8_WAIT_L(0); PG8_BAR; PG8_MMA(1, 0, At, B0); PG8_MMA(1, 1, At, B1); PG8_BAR; PG8_SCHED;
            } else {
            PG8_LDB(B0, 0, 0); PG8_SCHED; PG8_LDA(At, 0, 0); PG8_STAGE(PG8_SA(1, 1), a1 + hstep, voffA);
            PG8_WAIT_L(8); PG8_BAR; PG8_WAIT_L(0); PG8_MMA(0, 0, At, B0); PG8_BAR; PG8_SCHED;
            PG8_LDB(B1, 0, 1); PG8_STAGE(PG8_SB(0, 0), b2, voffB);
            PG8_BAR; PG8_WAIT_L(0); PG8_MMA(0, 1, At, B1); PG8_BAR;
            PG8_LDA(At, 0, 1); PG8_STAGE(PG8_SA(0, 0), a2, voffA);
            PG8_BAR; PG8_WAIT_L(0); PG8_MMA(1, 0, At, B0); PG8_BAR; PG8_SCHED;
            PG8_STAGE(PG8_SB(0, 1), b2 + hstep, voffB);
            PG8_WAIT_V(6); PG8_BAR; PG8_MMA(1, 1, At, B1); PG8_BAR;
            PG8_LDB(B0, 1, 0); PG8_SCHED; PG8_LDA(At, 1, 0); PG8_STAGE(PG8_SA(0, 1), a2 + hstep, voffA);
            PG8_WAIT_L(8); PG8_BAR; PG8_WAIT_L(0); PG8_MMA(0, 0, At, B0); PG8_BAR; PG8_SCHED;
            PG8_LDB(B1, 1, 1); PG8_STAGE(PG8_SB(1, 0), b3, voffB);
            PG8_BAR; PG8_WAIT_L(0); PG8_MMA(0, 1, At, B1); PG8_BAR;
            PG8_LDA(At, 1, 1); PG8_STAGE(PG8_SA(1, 0), a3, voffA);
            PG8_BAR; PG8_WAIT_L(0); PG8_MMA(1, 0, At, B0); PG8_BAR; PG8_SCHED;
            PG8_STAGE(PG8_SB(1, 1), b3 + hstep, voffB);
            PG8_WAIT_V(6); PG8_BAR; PG8_MMA(1, 1, At, B1); PG8_BAR;
            }
        }
        if constexpr (ALIGN_EPI) { if (wr == 0) PG8_BAR; }
        if constexpr (!Epi::AFTER_DRAIN) { E(acc, cur, wr, wc, fr, fq); S.done(cur); }
        if (!has_next) break;
#pragma unroll
        for (int a = 0; a < 2; ++a)
#pragma unroll
            for (int b = 0; b < 2; ++b)
#pragma unroll
                for (int m = 0; m < 4; ++m)
#pragma unroll
                    for (int n = 0; n < 2; ++n) acc[a][b][m][n] = (f32x4){0.f, 0.f, 0.f, 0.f};
        cur = nxt; cA = nA; cB = nB; ++ui;
        if constexpr (ALIGN_EPI) { if (wr == 1) PG8_BAR; }
    }
    PG8_WAIT_V(0);
    if constexpr (!ALIGN_EPI) { if (wr == 0) PG8_BAR; }
    PG8_BAR;
    if constexpr (Epi::AFTER_DRAIN) { E.fused(acc, cur, wr, wc, fr, fq, lds, wid, lane); S.done(cur); }
#undef PG8_SA
#undef PG8_SB
#undef PG8_STAGE
#undef PG8_LDA
#undef PG8_LDB
#undef PG8_MMA
#undef PG8_WAIT_V
#undef PG8_WAIT_L
#undef PG8_BAR
#undef PG8_SCHED
}
}
#define LAS __attribute__((address_space(3)))
__device__ __forceinline__ int opaque_tid() { int t = threadIdx.x; asm volatile("" : "+v"(t)); return t; }
using pg8::bf16_t; using pg8::bf16x8; using pg8::f32x4; using pg8::u32x4;
typedef short s16x4 __attribute__((ext_vector_type(4)));
typedef float f32x16 __attribute__((ext_vector_type(16)));
typedef unsigned u32x2 __attribute__((ext_vector_type(2)));
constexpr int M_TOK = 32768, DM = 1024, SEQ = 4096, FFD = 2816;
constexpr size_t KiB = 1024, MiB = 1024 * 1024;
constexpr size_t WS_CSP = 1 * MiB, WS_CSM = 1 * MiB + 256 * KiB;
constexpr size_t WS_W = 2 * MiB, W_LSTRIDE = 35 * MiB;
constexpr size_t W13_OFF0 = 0, W2_OFF0 = 11 * MiB, W13_OFF1 = 16 * MiB + 512 * KiB, W2_OFF1 = 27 * MiB + 512 * KiB, WOUT_OFF = 33 * MiB;
constexpr size_t WS_WDSA = 142 * MiB, WDSA_STRIDE = 7 * MiB + 512 * KiB, WS_WFOX = 157 * MiB, WS_WDQKV = 163 * MiB + 512 * KiB, WS_WUQ = 165 * MiB, WS_WUKV = 166 * MiB + 128 * KiB;
constexpr size_t WS_XB = 168 * MiB, WS_BIG = 232 * MiB, WS_EXT = 424 * MiB;
constexpr int LDS_BYTES = 147456;
constexpr float ALPHA_DN = 1.681792830507429f;

__device__ __forceinline__ float wave_sum(float v) {
#pragma unroll
    for (int o = 1; o < 64; o <<= 1) v += __shfl_xor(v, o);
    return v;
}
#define LDS_WAIT() asm volatile("s_waitcnt lgkmcnt(0)" ::: "memory")

struct Params { const float* in[16]; float* out; unsigned char* ws; int ph_lo, ph_hi; };

__device__ __forceinline__ int srccol(int mode, int n, int Nsrc) {
    if (mode == 0) return n < Nsrc ? n : -1;
    if (mode == 1) { const int t = n >> 8, r = n & 255; return r < 128 ? t * 128 + r : 2816 + t * 128 + (r - 128); }
    if (mode == 2) {
        if (n >= 3656) return -1;
        if (n < 2048 || (n >= 3072 && n < 3648)) { const int j = n & 63; if (j < 16) return (n - j) + ((j & 1) ? 8 + (j >> 1) : (j >> 1)); }
        return n;
    }
    if (mode == 4) {
        if (n < 1024) return (n >> 6) * 96 + (n & 63);
        const int r = n - 1024, h = r >> 5, jj = r & 31; return h * 96 + 64 + ((jj & 1) ? 16 + (jj >> 1) : (jj >> 1));
    }
    if (n < 1024) return (n >> 6) * 128 + (n & 63);
    { const int r = n - 1024; return (r >> 6) * 128 + 64 + (r & 63); }
}
__device__ __forceinline__ void transpose_item(const float* W, int K, int Nsrc, bf16_t* WT, int mode, const float* gain, LAS float* scr, int item, int nblk, int lane) {
    const int kb = item / nblk, nb = item % nblk, k0 = 64 * kb, n0 = 32 * nb;
    const int sc = srccol(mode, n0 + (lane & 31), Nsrc);
#pragma unroll 8
    for (int i = 0; i < 32; ++i) { const int kk = 2 * i + (lane >> 5); float v = 0.f;
        if (sc >= 0) { v = W[(size_t)(k0 + kk) * Nsrc + sc]; if (gain) v *= gain[k0 + kk]; }
        scr[kk * 33 + (lane & 31)] = v; }
    LDS_WAIT(); asm volatile("" ::: "memory");
    const int c = lane & 7;
#pragma unroll
    for (int j = 0; j < 4; ++j) { const int n = (lane >> 3) + 8 * j; const LAS float* s = scr + (8 * c) * 33 + n;
        u32x4 o; o.x = pk_bf16(s[0 * 33], s[1 * 33]); o.y = pk_bf16(s[2 * 33], s[3 * 33]); o.z = pk_bf16(s[4 * 33], s[5 * 33]); o.w = pk_bf16(s[6 * 33], s[7 * 33]);
        *(u32x4*)(WT + (size_t)(n0 + n) * K + k0 + 8 * c) = o; }
    LDS_WAIT(); asm volatile("" ::: "memory");
}
__device__ __forceinline__ void prologue_phase(LAS unsigned char* lds, const Params& p, int G, int bid) {
    const int tid = opaque_tid(), lane = tid & 63, wid = __builtin_amdgcn_readfirstlane(tid >> 6);
    LAS float* scr = (LAS float*)(lds + wid * 8448);
    const int gw = bid * 8 + wid, NGW = G * 8;
    unsigned char* ws = p.ws;
    for (int j = 0; j < 26; ++j) {
        const float* W; const float* gain = nullptr; bf16_t* WT; int K = 1024, Nsrc, Npad, mode = 0;
        if (j < 16) { const int L = j >> 2, w = j & 3; unsigned char* lb = ws + WS_W + (size_t)L * W_LSTRIDE;
            if (w == 0) { W = p.in[1] + (size_t)L * 1024 * 5632; Nsrc = 5632; Npad = 5632; mode = 1; WT = (bf16_t*)(lb + W13_OFF0); }
            else if (w == 1) { W = p.in[2] + (size_t)L * 2816 * 1024; K = 2816; Nsrc = 1024; Npad = 1024; WT = (bf16_t*)(lb + W2_OFF0); }
            else if (w == 2) { W = p.in[3] + (size_t)L * 1024 * 5632; Nsrc = 5632; Npad = 5632; mode = 1; WT = (bf16_t*)(lb + W13_OFF1); }
            else { W = p.in[4] + (size_t)L * 2816 * 1024; K = 2816; Nsrc = 1024; Npad = 1024; WT = (bf16_t*)(lb + W2_OFF1); } }
        else if (j < 20) { const int L = j - 16; W = p.in[7] + (size_t)L * 1024 * 1024; Nsrc = 1024; Npad = 1024; WT = (bf16_t*)(ws + WS_W + (size_t)L * W_LSTRIDE + WOUT_OFF); }
        else if (j < 22) { W = p.in[8] + (size_t)(j - 20) * 1024 * 3656; Nsrc = 3656; Npad = 3840; mode = 2; WT = (bf16_t*)(ws + WS_WDSA + (size_t)(j - 20) * WDSA_STRIDE); }
        else if (j == 22) { W = p.in[9]; Nsrc = 3088; Npad = 3328; WT = (bf16_t*)(ws + WS_WFOX); }
        else if (j == 23) { W = p.in[11]; Nsrc = 672; Npad = 768; WT = (bf16_t*)(ws + WS_WDQKV); }
        else if (j == 24) { W = p.in[13]; K = 384; Nsrc = 1536; Npad = 1536; mode = 4; gain = p.in[12]; WT = (bf16_t*)(ws + WS_WUQ); }
        else { W = p.in[15]; K = 256; Nsrc = 2048; Npad = 2048; mode = 5; gain = p.in[14]; WT = (bf16_t*)(ws + WS_WUKV); }
        const int nblk = Npad / 32, nitems = (K / 64) * nblk;
        for (int it = gw; it < nitems; it += NGW) transpose_item(W, K, Nsrc, WT, mode, gain, scr, it, nblk, lane);
    }
    { const f32x4* x4 = (const f32x4*)p.in[0]; f32x4* o4 = (f32x4*)p.out; u32x2* xb = (u32x2*)(ws + WS_XB);
      const int nth = G * 512;
      for (int i = bid * 512 + tid; i < M_TOK * DM / 4; i += nth) { const f32x4 v = x4[i]; o4[i] = v; u32x2 w; w.x = pk_bf16(v[0], v[1]); w.y = pk_bf16(v[2], v[3]); xb[i] = w; } }
    { float* csp = (float*)(ws + WS_CSP); float* csm = (float*)(ws + WS_CSM); const int nth = G * 512;
      for (int i = bid * 512 + tid; i < 32768 + 65536; i += nth) {
          int t, d; float inv; float* dst;
          if (i < 32768) { t = i >> 3; d = i & 7; inv = powf(500000.0f, -(float)d * 0.125f); dst = csp + (size_t)i * 2; }
          else { const int i2 = i - 32768; t = i2 >> 4; d = i2 & 15; inv = powf(500000.0f, -(float)d * 0.0625f); dst = csm + (size_t)i2 * 2; }
          const float ang = (float)t * inv; dst[0] = cosf(ang); dst[1] = sinf(ang); } }
}

__device__ __forceinline__ void ln_phase(float* X, bf16_t* XB, const float* g, const float* b, int G, int bid) {
    const int tid = opaque_tid(), lane = tid & 63, wid = __builtin_amdgcn_readfirstlane(tid >> 6);
    const int gw = bid * 8 + wid, NGW = G * 8;
    f32x4 gv[4], bv[4];
#pragma unroll
    for (int j = 0; j < 4; ++j) { gv[j] = ((const f32x4*)g)[lane + 64 * j]; bv[j] = ((const f32x4*)b)[lane + 64 * j]; }
    for (int row = gw; row < M_TOK; row += NGW) {
        f32x4* xr = (f32x4*)(X + (size_t)row * DM) + lane;
        f32x4 v[4]; float s = 0.f;
#pragma unroll
        for (int j = 0; j < 4; ++j) { v[j] = xr[64 * j]; s += (v[j][0] + v[j][1]) + (v[j][2] + v[j][3]); }
        const float mean = wave_sum(s) * (1.f / DM); float s2 = 0.f;
#pragma unroll
        for (int j = 0; j < 4; ++j) { v[j] = v[j] - mean; s2 += (v[j][0] * v[j][0] + v[j][1] * v[j][1]) + (v[j][2] * v[j][2] + v[j][3] * v[j][3]); }
        const float rstd = 1.f / sqrtf(wave_sum(s2) * (1.f / DM) + 1e-5f);
        u32x2* o8 = (u32x2*)(XB + (size_t)row * DM) + lane;
#pragma unroll
        for (int j = 0; j < 4; ++j) { const f32x4 y = v[j] * rstd * gv[j] + bv[j]; xr[64 * j] = y; u32x2 w; w.x = pk_bf16(y[0], y[1]); w.y = pk_bf16(y[2], y[3]); o8[64 * j] = w; }
    }
}

__device__ __forceinline__ void fox_scan_phase(LAS unsigned char* lds, const float* LF, float* CUM, int G, int bid) {
    const int tid = opaque_tid(), lane = tid & 63, wid = tid >> 6;
    LAS float* wt = (LAS float*)lds;
    for (int seq = bid; seq < 128; seq += G) {
        const int b = seq >> 4, h = seq & 15;
        float v[8]; float run = 0.f;
#pragma unroll
        for (int e = 0; e < 8; ++e) { run += LF[((size_t)b * SEQ + tid * 8 + e) * 16 + h]; v[e] = run; }
        float x = run;
#pragma unroll
        for (int o = 1; o < 64; o <<= 1) { const float y = __shfl_up(x, o); if (lane >= o) x += y; }
        if (lane == 63) wt[wid] = x;
        __syncthreads();
        float off = x - run;
        for (int w = 0; w < wid; ++w) off += wt[w];
        float* dst = CUM + (size_t)seq * SEQ + tid * 8;
        f32x4 o0 = {v[0] + off, v[1] + off, v[2] + off, v[3] + off}, o1 = {v[4] + off, v[5] + off, v[6] + off, v[7] + off};
        *(f32x4*)dst = o0; *(f32x4*)(dst + 4) = o1;
        __syncthreads();
    }
}

__device__ __forceinline__ void mla_norm_phase(const bf16_t* C, bf16_t* CQN, bf16_t* CKVN, bf16_t* KR, const float* csm, int G, int bid) {
    const int tid = opaque_tid(), lane = tid & 63, wid = __builtin_amdgcn_readfirstlane(tid >> 6);
    const int gw = bid * 8 + wid, NGW = G * 8;
    for (int row = gw; row < M_TOK; row += NGW) {
        const bf16_t* c = C + (size_t)row * 768;
        float q[8]; float s1 = 0.f;
        if (lane < 48) { const u32x4 r = *(const u32x4*)(c + lane * 8);
            q[0] = bf_lo(r.x); q[1] = bf_hi(r.x); q[2] = bf_lo(r.y); q[3] = bf_hi(r.y); q[4] = bf_lo(r.z); q[5] = bf_hi(r.z); q[6] = bf_lo(r.w); q[7] = bf_hi(r.w);
#pragma unroll
            for (int e = 0; e < 8; ++e) s1 += q[e] * q[e]; }
        else {
#pragma unroll
            for (int e = 0; e < 8; ++e) q[e] = 0.f; }
        const float rq = 1.0f / sqrtf(wave_sum(s1) * (1.f / 384.f) + 1e-6f);
        const u32x2 r2 = *(const u32x2*)(c + 384 + lane * 4);
        float k0 = bf_lo(r2.x), k1 = bf_hi(r2.x), k2 = bf_lo(r2.y), k3 = bf_hi(r2.y);
        const float rk = 1.0f / sqrtf(wave_sum(k0 * k0 + k1 * k1 + k2 * k2 + k3 * k3) * (1.f / 256.f) + 1e-6f);
        if (lane < 48) { u32x4 w; w.x = pk_bf16(q[0] * rq, q[1] * rq); w.y = pk_bf16(q[2] * rq, q[3] * rq); w.z = pk_bf16(q[4] * rq, q[5] * rq); w.w = pk_bf16(q[6] * rq, q[7] * rq);
            *(u32x4*)(CQN + (size_t)row * 384 + lane * 8) = w; }
        { u32x2 w; w.x = pk_bf16(k0 * rk, k1 * rk); w.y = pk_bf16(k2 * rk, k3 * rk); *(u32x2*)(CKVN + (size_t)row * 256 + lane * 4) = w; }
        if (lane < 16) { const int t = row & 4095; const float x1 = __uint_as_float((unsigned)c[640 + lane] << 16), x2 = __uint_as_float((unsigned)c[656 + lane] << 16);
            const float cs = csm[((size_t)t * 16 + lane) * 2], sn = csm[((size_t)t * 16 + lane) * 2 + 1];
            *(unsigned*)(KR + (size_t)row * 32 + 2 * lane) = pk_bf16(x1 * cs - x2 * sn, x1 * sn + x2 * cs); }
    }
}

#define MFMA32(a, b, c) __builtin_amdgcn_mfma_f32_32x32x16_bf16((a), (b), (c), 0, 0, 0)
template <int NV>
__device__ __forceinline__ void dsa_select(const LAS unsigned* row, int nch, int lane, unsigned long long* mrow) {
    unsigned v[NV];
#pragma unroll
    for (int c = 0; c < NV; ++c) v[c] = (c < nch) ? row[64 * c + lane] : 0u;
    unsigned T = 0u; bool exact = false;
    for (int bit = 31; bit >= 0; --bit) {
        const unsigned cand = T | (1u << bit); int cnt = 0;
#pragma unroll
        for (int c = 0; c < NV; ++c) { cnt += __popcll(__ballot(v[c] >= cand)); asm volatile("" : "+s"(cnt)); }
        if (cnt >= 256) { T = cand; if (cnt == 256) { exact = true; break; } }
    }
    int r = 1 << 30;
    if (!exact) { int ngt = 0;
#pragma unroll
        for (int c = 0; c < NV; ++c) { ngt += __popcll(__ballot(v[c] > T)); asm volatile("" : "+s"(ngt)); }
        r = 256 - ngt; }
    unsigned long long myword = 0ull;
#pragma unroll
    for (int c = 0; c < NV; ++c) {
        const unsigned long long gt = __ballot(v[c] > T); unsigned long long eq = __ballot(v[c] == T);
        const int pe = __popcll(eq); const int take = pe < r ? pe : (r > 0 ? r : 0);
        for (int drop = pe - take; drop > 0; --drop) eq &= ~(1ull << (63 - __clzll(eq)));
        r -= take; const unsigned long long word = gt | eq;
        if (lane == c) myword = word;
        asm volatile("" : "+s"(r), "+v"(myword));
    }
    mrow[lane] = myword;
}
__device__ __forceinline__ void dsa_index_phase(LAS unsigned char* lds, const bf16_t* QI, const bf16_t* KI, const float* WI, unsigned long long* MASK, int G, int bid) {
    LAS unsigned* sc = (LAS unsigned*)lds;
    const int tid = opaque_tid(), lane = tid & 63, wid = __builtin_amdgcn_readfirstlane(tid >> 6), lq = lane & 31, hi = lane >> 5;
    for (int u = bid; u < 4096; u += G) {
        const int b = u >> 9, t0 = (u & 511) * 8; const size_t rowbase = (size_t)b * SEQ;
        if (t0 < 256) {
            const int t = t0 + wid, nb = t + 1 - 64 * lane;
            const unsigned long long word = nb >= 64 ? ~0ull : (nb <= 0 ? 0ull : ((1ull << nb) - 1ull));
            MASK[(rowbase + t) * 64 + lane] = word;
            continue;
        }
        const int nch = (t0 + 8 + 63) >> 6, ntile = 2 * nch;
        bf16x8 qa[2][4];
#pragma unroll
        for (int mt = 0; mt < 2; ++mt)
#pragma unroll
            for (int s = 0; s < 4; ++s) qa[mt][s] = *(const bf16x8*)(QI + (rowbase + t0 + 4 * mt + (lq >> 3)) * 512 + (lq & 7) * 64 + 16 * s + 8 * hi);
        f32x4 w4[8];
#pragma unroll
        for (int tl = 0; tl < 8; ++tl) w4[tl] = *(const f32x4*)(WI + (rowbase + t0 + tl) * 8 + 4 * hi);
        bf16x8 kn[4];
        const bf16_t* kbase = KI + (rowbase + lq) * 64 + 8 * hi;
#pragma unroll
        for (int s = 0; s < 4; ++s) kn[s] = *(const bf16x8*)(kbase + (size_t)wid * 32 * 64 + 16 * s);
        for (int tile = wid; tile < ntile; tile += 8) {
            const int key0 = tile * 32;
            bf16x8 kb[4];
#pragma unroll
            for (int s = 0; s < 4; ++s) kb[s] = kn[s];
            if (tile + 8 < ntile) {
#pragma unroll
                for (int s = 0; s < 4; ++s) kn[s] = *(const bf16x8*)(kbase + (size_t)(tile + 8) * 32 * 64 + 16 * s);
            }
            f32x16 c0, c1;
#pragma unroll
            for (int i = 0; i < 16; ++i) { c0[i] = 0.f; c1[i] = 0.f; }
#pragma unroll
            for (int s = 0; s < 4; ++s) { c0 = MFMA32(qa[0][s], kb[s], c0); c1 = MFMA32(qa[1][s], kb[s], c1); }
            float part[8];
#pragma unroll
            for (int g = 0; g < 4; ++g) {
                part[g] = (w4[g][0] * fmaxf(c0[4 * g], 0.f) + w4[g][1] * fmaxf(c0[4 * g + 1], 0.f)) + (w4[g][2] * fmaxf(c0[4 * g + 2], 0.f) + w4[g][3] * fmaxf(c0[4 * g + 3], 0.f));
                part[4 + g] = (w4[4 + g][0] * fmaxf(c1[4 * g], 0.f) + w4[4 + g][1] * fmaxf(c1[4 * g + 1], 0.f)) + (w4[4 + g][2] * fmaxf(c1[4 * g + 2], 0.f) + w4[4 + g][3] * fmaxf(c1[4 * g + 3], 0.f));
            }
#pragma unroll
            for (int tl = 0; tl < 8; ++tl) part[tl] += __shfl_xor(part[tl], 32);
            const int key = key0 + lq;
#pragma unroll
            for (int k = 0; k < 4; ++k) {
                const int tl = 4 * hi + k; const unsigned hm_ = (unsigned)(-hi); float f = __uint_as_float((__float_as_uint(part[k]) & ~hm_) | (__float_as_uint(part[4 + k]) & hm_));
                f = (f == 0.f) ? 0.f : f;
                const unsigned bits = __float_as_uint(f); unsigned uu = (bits & 0x80000000u) ? ~bits : (bits | 0x80000000u);
                if (key > t0 + tl) uu = 0u;
                sc[tl * 4096 + key] = uu;
            }
        }
        __syncthreads();
        {
            const LAS unsigned* row = sc + wid * 4096; unsigned long long* mrow = MASK + (rowbase + t0 + wid) * 64;
            if (nch <= 32) dsa_select<32>(row, nch, lane, mrow); else dsa_select<64>(row, nch, lane, mrow);
        }
        __syncthreads();
    }
}

struct AttnArgs { const bf16_t* Q; const bf16_t* K; const bf16_t* V; bf16_t* O; const bf16_t* QR; const bf16_t* KR; const float* CUM; const unsigned long long* MASK; };
template <int MODE>
__device__ __forceinline__ void attn_phase(LAS unsigned char* lds, const AttnArgs a, int G, int bid) {
    constexpr int DQK = (MODE == 2) ? 96 : 64, NKS = DQK / 16, KROW = (DQK + 8) * 2, VROW = 144;
    constexpr int KBUF = 64 * KROW, VBUF = 64 * VROW, OFF_K = 0, OFF_V = 2 * KBUF, OFF_C = OFF_V + 2 * VBUF;
    const int tid = opaque_tid(), lane = tid & 63, wid = __builtin_amdgcn_readfirstlane(tid >> 6), lq = lane & 31, hi = lane >> 5;
    const int qq = (lane & 15) >> 2, pp = lane & 3, blk = (lane >> 4) & 1;
    const float NEG = -__builtin_inff();
    for (int ui = bid; ui < 2048; ui += G) {
        const int w = ui & 255, j = ui >> 8, xcd = w & 7, ii = w >> 3, bh = xcd + 8 * (ii >> 1), half = ii & 1, jj = j >> 1;
        const int qb = half == 0 ? ((j & 1) ? 12 - 4 * jj : 15 - 4 * jj) : ((j & 1) ? 13 - 4 * jj : 14 - 4 * jj);
        const int b = bh >> 4, h = bh & 15; const size_t rowbase = (size_t)b * SEQ;
        const int q0 = qb * 256 + wid * 32, qg = q0 + lq, nkt = 4 * qb + 4, ktd = q0 >> 6;
        bf16x8 qf[NKS];
#pragma unroll
        for (int s = 0; s < 4; ++s) qf[s] = *(const bf16x8*)(a.Q + (rowbase + qg) * 1024 + h * 64 + 16 * s + 8 * hi);
        if constexpr (MODE == 2) {
#pragma unroll
            for (int s = 4; s < 6; ++s) qf[s] = *(const bf16x8*)(a.QR + (rowbase + qg) * 512 + h * 32 + 16 * (s - 4) + 8 * hi);
        }
        f32x16 o0, o1;
#pragma unroll
        for (int i = 0; i < 16; ++i) { o0[i] = 0.f; o1[i] = 0.f; }
        float m_run = -1e30f, l_run = 0.f;
        u32x4 rk, rv, rk2 = {0u, 0u, 0u, 0u}; float rc = 0.f;
        unsigned long long mw_cur = 0ull, mw_next = 0ull;
        const int lrow = tid >> 3, lcc = tid & 7;
#define ATT_LOADG(kt_) do { const size_t gr_ = rowbase + 64 * (kt_) + lrow; \
            rk = *(const u32x4*)(a.K + gr_ * 1024 + h * 64 + lcc * 8); rv = *(const u32x4*)(a.V + gr_ * 1024 + h * 64 + lcc * 8); \
            if constexpr (MODE == 2) { if (tid < 256) rk2 = *(const u32x4*)(a.KR + (rowbase + 64 * (kt_) + (tid >> 2)) * 32 + (tid & 3) * 8); } \
            if constexpr (MODE == 1) { if (tid < 64) rc = a.CUM[(size_t)bh * SEQ + 64 * (kt_) + tid]; } } while (0)
#define ATT_STORE(buf_) do { *(LAS u32x4*)(lds + OFF_K + (buf_) * KBUF + lrow * KROW + lcc * 16) = rk; *(LAS u32x4*)(lds + OFF_V + (buf_) * VBUF + lrow * VROW + lcc * 16) = rv; \
            if constexpr (MODE == 2) { if (tid < 256) *(LAS u32x4*)(lds + OFF_K + (buf_) * KBUF + (tid >> 2) * KROW + 128 + (tid & 3) * 16) = rk2; } \
            if constexpr (MODE == 1) { if (tid < 64) *(LAS float*)(lds + OFF_C + (buf_) * 256 + tid * 4) = rc; } } while (0)
        ATT_LOADG(0); ATT_STORE(0);
        if constexpr (MODE == 0) mw_cur = a.MASK[(rowbase + qg) * 64];
        __syncthreads();
        for (int kt = 0; kt < nkt; ++kt) {
            const int buf = kt & 1;
            if (kt + 1 < nkt) ATT_LOADG(kt + 1);
            if constexpr (MODE == 0) { if (kt + 1 <= ktd) mw_next = a.MASK[(rowbase + qg) * 64 + kt + 1]; }
            if (kt <= ktd) {
                const LAS unsigned char* kbp = lds + OFF_K + buf * KBUF; const LAS unsigned char* vbp = lds + OFF_V + buf * VBUF;
                f32x16 s0, s1;
#pragma unroll
                for (int i = 0; i < 16; ++i) { s0[i] = 0.f; s1[i] = 0.f; }
#pragma unroll
                for (int s = 0; s < NKS; ++s) {
                    const bf16x8 a0 = *(const LAS bf16x8*)(kbp + lq * KROW + (16 * s + 8 * hi) * 2);
                    const bf16x8 a1 = *(const LAS bf16x8*)(kbp + (32 + lq) * KROW + (16 * s + 8 * hi) * 2);
                    s0 = MFMA32(a0, qf[s], s0); s1 = MFMA32(a1, qf[s], s1);
                }
                if constexpr (MODE == 1) {
                    const LAS unsigned char* cb = lds + OFF_C + buf * 256;
#pragma unroll
                    for (int g = 0; g < 4; ++g) { const f32x4 ca = *(const LAS f32x4*)(cb + (8 * g + 4 * hi) * 4), cc = *(const LAS f32x4*)(cb + (32 + 8 * g + 4 * hi) * 4);
#pragma unroll
                        for (int e = 0; e < 4; ++e) { s0[4 * g + e] -= ca[e]; s1[4 * g + e] -= cc[e]; } }
                }
                if constexpr (MODE == 0) {
                    const unsigned wl = (unsigned)mw_cur >> (4 * hi), wh = (unsigned)(mw_cur >> 32) >> (4 * hi);
#pragma unroll
                    for (int i = 0; i < 16; ++i) { const int pos = (i & 3) + 8 * (i >> 2); if (!((wl >> pos) & 1u)) s0[i] = NEG; if (!((wh >> pos) & 1u)) s1[i] = NEG; }
                } else {
                    if (kt == ktd) {
                        const int kbase = 64 * kt + 4 * hi;
#pragma unroll
                        for (int i = 0; i < 16; ++i) { const int kl = (i & 3) + 8 * (i >> 2); if (kbase + kl > qg) s0[i] = NEG; if (kbase + 32 + kl > qg) s1[i] = NEG; }
                    }
                }
                float mx = fmaxf(s0[0], s1[0]);
#pragma unroll
                for (int i = 1; i < 16; ++i) mx = fmaxf(mx, fmaxf(s0[i], s1[i]));
                mx = fmaxf(mx, __shfl_xor(mx, 32));
                const float mn = fmaxf(m_run, mx), alpha = __builtin_amdgcn_exp2f(m_run - mn);
                m_run = mn;
                float ls = 0.f;
#pragma unroll
                for (int i = 0; i < 16; ++i) { s0[i] = __builtin_amdgcn_exp2f(s0[i] - mn); s1[i] = __builtin_amdgcn_exp2f(s1[i] - mn); ls += s0[i] + s1[i]; }
                l_run = l_run * alpha + ls;
#pragma unroll
                for (int i = 0; i < 16; ++i) { o0[i] *= alpha; o1[i] *= alpha; }
                bf16x8 pf[4];
#pragma unroll
                for (int s = 0; s < 2; ++s) {
                    u32x4 t0, t1;
                    t0.x = pk_bf16(s0[8 * s], s0[8 * s + 1]); t0.y = pk_bf16(s0[8 * s + 2], s0[8 * s + 3]); t0.z = pk_bf16(s0[8 * s + 4], s0[8 * s + 5]); t0.w = pk_bf16(s0[8 * s + 6], s0[8 * s + 7]);
                    t1.x = pk_bf16(s1[8 * s], s1[8 * s + 1]); t1.y = pk_bf16(s1[8 * s + 2], s1[8 * s + 3]); t1.z = pk_bf16(s1[8 * s + 4], s1[8 * s + 5]); t1.w = pk_bf16(s1[8 * s + 6], s1[8 * s + 7]);
                    pf[s] = __builtin_bit_cast(bf16x8, t0); pf[2 + s] = __builtin_bit_cast(bf16x8, t1);
                }
#pragma unroll
                for (int ks = 0; ks < 4; ++ks) {
#pragma unroll
                    for (int dh = 0; dh < 2; ++dh) {
                        const LAS unsigned char* ap = vbp + (16 * ks + 4 * hi + qq) * VROW + (32 * dh + 16 * blk + 4 * pp) * 2;
                        const s16x4 lo4 = __builtin_amdgcn_ds_read_tr16_b64_v4i16((LAS s16x4*)ap);
                        const s16x4 hi4 = __builtin_amdgcn_ds_read_tr16_b64_v4i16((LAS s16x4*)(ap + 8 * VROW));
                        const bf16x8 av = __builtin_shufflevector(lo4, hi4, 0, 1, 2, 3, 4, 5, 6, 7);
                        if (dh == 0) o0 = MFMA32(av, pf[ks], o0); else o1 = MFMA32(av, pf[ks], o1);
                    }
                }
            }
            if (kt + 1 < nkt) ATT_STORE(buf ^ 1);
            __syncthreads();
            mw_cur = mw_next;
        }
        const float lt = l_run + __shfl_xor(l_run, 32), inv = 1.0f / lt;
        bf16_t* op = a.O + (rowbase + qg) * 1024 + h * 64 + 4 * hi;
#pragma unroll
        for (int g = 0; g < 4; ++g) {
            u32x2 w0, w1;
            w0.x = pk_bf16(o0[4 * g] * inv, o0[4 * g + 1] * inv); w0.y = pk_bf16(o0[4 * g + 2] * inv, o0[4 * g + 3] * inv);
            w1.x = pk_bf16(o1[4 * g] * inv, o1[4 * g + 1] * inv); w1.y = pk_bf16(o1[4 * g + 2] * inv, o1[4 * g + 3] * inv);
            *(u32x2*)(op + 8 * g) = w0; *(u32x2*)(op + 32 + 8 * g) = w1;
        }
#undef ATT_LOADG
#undef ATT_STORE
    }
}
#define XB_TMO      128
#define XB_XCNT(j)  (256  + 64 * (j))
#define XB_XSUB(j)  (1280 + 64 * (j))
#define XB_XGEN(j)  (2304 + 64 * (j))
#define XB_TOP      3328
#define XB_TOPGEN   3392
#define XCD_BAR_WORDS 3456
#define XB_SPIN_CAP (1u << 18)

__device__ __forceinline__ unsigned xb_ld(unsigned* p)              { return __hip_atomic_load(p, __ATOMIC_RELAXED, __HIP_MEMORY_SCOPE_AGENT); }
__device__ __forceinline__ unsigned xb_add(unsigned* p, unsigned v) { return __hip_atomic_fetch_add(p, v, __ATOMIC_RELAXED, __HIP_MEMORY_SCOPE_AGENT); }
__device__ __forceinline__ unsigned xb_xcc_id() { return (unsigned)__builtin_amdgcn_s_getreg((3 << 11) | 20) & 0xFu; }
#define XB_SPIN(cond, bar) do { unsigned _sp = 0; while (cond) { __builtin_amdgcn_s_sleep(1); \
    if ((++_sp & 255u) == 0u) { if (xb_ld(&(bar)[XB_TMO])) break; if (_sp > XB_SPIN_CAP) { atomicAdd(&(bar)[XB_TMO], 1u); break; } } } } while (0)

struct XcdBarrier {
    unsigned* bar; unsigned x;
    volatile LAS unsigned* st;
};

__device__ __forceinline__ XcdBarrier xcd_barrier_post(unsigned* bar, volatile LAS unsigned* st) {
    XcdBarrier b; b.bar = bar; b.x = xb_xcc_id(); b.st = st;
    if (threadIdx.x == 0) (void)xb_add(&bar[XB_XCNT(b.x)], 1u);
    return b;
}
__device__ __forceinline__ void xcd_barrier_complete(unsigned* bar, unsigned x, unsigned& nloc, unsigned& nx) {
    const unsigned G = gridDim.x * gridDim.y * gridDim.z;
    unsigned sum, cnt, mine, sp = 0u;
    for (;;) {
        sum = 0u; cnt = 0u; mine = 0u;
#pragma unroll
        for (unsigned j = 0; j < 16; ++j) { const unsigned c = xb_ld(&bar[XB_XCNT(j)]); sum += c; cnt += (c > 0u) ? 1u : 0u; mine = (j == x) ? c : mine; }
        if (sum == G) break;
        __builtin_amdgcn_s_sleep(1);
        if ((++sp & 255u) == 0u) { if (xb_ld(&bar[XB_TMO])) break; if (sp > XB_SPIN_CAP) { atomicAdd(&bar[XB_TMO], 1u); break; } }
    }
    nloc = mine > 0u ? mine : 1u; nx = cnt > 0u ? cnt : 1u;
}

__device__ __forceinline__ void xcd_barrier(const XcdBarrier& b) {
    asm volatile("s_waitcnt vmcnt(0)" ::: "memory");
    __syncthreads();
    if (threadIdx.x == 0) {
        unsigned* bar = b.bar;
        __builtin_amdgcn_s_waitcnt(0);
        unsigned nloc = b.st[0], nx = b.st[1];
        if (nloc == 0u) { xcd_barrier_complete(bar, b.x, nloc, nx); b.st[0] = nloc; b.st[1] = nx; }
        const unsigned old = xb_add(&bar[XB_XSUB(b.x)], 1u);
        const unsigned gen = old / nloc;
        if (old + 1u == (gen + 1u) * nloc) {
            __builtin_amdgcn_fence(__ATOMIC_RELEASE, "agent");
            asm volatile("s_waitcnt vmcnt(0)" ::: "memory");
            const unsigned og = xb_add(&bar[XB_TOP], 1u);
            const unsigned tg = og / nx;
            if (og + 1u == (tg + 1u) * nx) xb_add(&bar[XB_TOPGEN], 1u);
            else XB_SPIN(xb_ld(&bar[XB_TOPGEN]) == tg, bar);
            __builtin_amdgcn_fence(__ATOMIC_ACQUIRE, "agent");
            xb_add(&bar[XB_XGEN(b.x)], 1u);
            asm volatile("s_waitcnt vmcnt(0)" ::: "memory");
        } else {
            XB_SPIN(xb_ld(&bar[XB_XGEN(b.x)]) == gen, bar);
            __builtin_amdgcn_fence(__ATOMIC_ACQUIRE, "agent");
            asm volatile("s_waitcnt vmcnt(0)" ::: "memory");
        }
    }
    __syncthreads();
}
#ifndef REP_SYNC
#define REP_SYNC 1
#endif
#ifndef REP_PRO
#define REP_PRO 1
#endif
#ifndef REP_ATTN
#define REP_ATTN 1
#endif
#ifndef REP_IDX
#define REP_IDX 1
#endif
#ifndef REP_G13
#define REP_G13 1
#endif
__global__ void __launch_bounds__(512, 2) mega(Params p) {
    extern __shared__ __attribute__((aligned(16))) unsigned char lds_raw[];
    LAS unsigned char* lds = (LAS unsigned char*)lds_raw;
    cg::grid_group grid = cg::this_grid();
    const int G = gridDim.x, bid = blockIdx.x;
    unsigned char* ws = p.ws;
    int ph = 0; const int lo = p.ph_lo, hi = p.ph_hi;
    volatile LAS unsigned* bst = (volatile LAS unsigned*)(lds + 131072 + 64);
    if (threadIdx.x < 2) bst[threadIdx.x] = 0u;
    __syncthreads();
    XcdBarrier xbar = xcd_barrier_post((unsigned*)(ws + 0), bst);
#define RUN() (ph >= lo && ph < hi)
#define SEAM() do { if (ph >= lo && ph + 1 < hi) { for (int rs_ = 0; rs_ < REP_SYNC; ++rs_) { if (ph == 0) grid.sync(); else xcd_barrier(xbar); } } ++ph; } while (0)
    bf16_t* XB = (bf16_t*)(ws + WS_XB);
    bf16_t* HB = (bf16_t*)(ws + WS_BIG);
    bf16_t* QO = (bf16_t*)(ws + WS_BIG); bf16_t* KB = (bf16_t*)(ws + WS_BIG + 64 * MiB); bf16_t* VB = (bf16_t*)(ws + WS_BIG + 128 * MiB);
    const float* csp = (const float*)(ws + WS_CSP); const float* csm = (const float*)(ws + WS_CSM);
    bf16_t* QI = (bf16_t*)(ws + WS_EXT); bf16_t* KI = (bf16_t*)(ws + WS_EXT + 32 * MiB); float* WI = (float*)(ws + WS_EXT + 36 * MiB); unsigned long long* MASK = (unsigned long long*)(ws + WS_EXT + 37 * MiB);
    float* LF = (float*)(ws + WS_EXT); float* CUM = (float*)(ws + WS_EXT + 2 * MiB);
    bf16_t* CQN = (bf16_t*)(ws + WS_EXT); bf16_t* CKVN = (bf16_t*)(ws + WS_EXT + 24 * MiB); bf16_t* KR = (bf16_t*)(ws + WS_EXT + 40 * MiB); bf16_t* QR = (bf16_t*)(ws + WS_EXT + 42 * MiB);
    bf16_t* CB = (bf16_t*)(ws + WS_BIG);

    if (RUN()) for (int rep = 0; rep < REP_PRO; ++rep) prologue_phase(lds, p, G, bid);
    SEAM();
    for (int L = 0; L < 4; ++L) {
        const int kind = L % 3, jm = L / 3;
        unsigned char* lw = ws + WS_W + (size_t)L * W_LSTRIDE;
        for (int sub = 0; sub < 3; ++sub) {
            if (sub != 1) {
                if (RUN()) {
                    pg8::Gemm g{XB, (const bf16_t*)(lw + (sub == 0 ? W13_OFF0 : W13_OFF1)), M_TOK, 5632, 1024};
                    pg8::StaticOrder S; S.init(M_TOK, 5632, G, bid);
                    pg8::EpiSwiglu E{HB};
                    for (int rep = 0; rep < REP_G13; ++rep) pg8::gemm_phase<pg8::EpiSwiglu, pg8::StaticOrder, true, true>(lds, g, S, E);
                }
                SEAM();
            } else {
                if (RUN()) {
                    pg8::EpiProj E{}; E.QO = QO; E.KB = KB; E.VB = VB; E.csp = csp; E.csm = csm; E.wscale = 0.35355339059327373f * 0.125f;
                    const bf16_t* Bt; int N;
                    if (kind == 0) { E.mode = 1; E.X0 = QI; E.KI = KI; E.F0 = WI; E.qscale = 0.125f * LOG2E; Bt = (const bf16_t*)(ws + WS_WDSA + (size_t)jm * WDSA_STRIDE); N = 3840; }
                    else if (kind == 1) { E.mode = 2; E.F0 = LF; E.bfox = p.in[10]; E.qscale = 0.125f * LOG2E; Bt = (const bf16_t*)(ws + WS_WFOX); N = 3328; }
                    else { E.mode = 3; E.X0 = CB; E.qscale = 1.f; Bt = (const bf16_t*)(ws + WS_WDQKV); N = 768; }
                    pg8::Gemm g{XB, Bt, M_TOK, N, 1024};
                    pg8::StaticOrder S; S.init(M_TOK, N, G, bid);
                    pg8::gemm_phase<pg8::EpiProj, pg8::StaticOrder, true, true>(lds, g, S, E);
                }
                SEAM();
                if (kind == 0) {
                    if (RUN()) for (int rep = 0; rep < REP_IDX; ++rep) dsa_index_phase(lds, QI, KI, WI, MASK, G, bid);
                    SEAM();
                    if (RUN()) { AttnArgs a{QO, KB, VB, XB, nullptr, nullptr, nullptr, MASK}; for (int rep = 0; rep < REP_ATTN; ++rep) attn_phase<0>(lds, a, G, bid); }
                    SEAM();
                } else if (kind == 1) {
                    if (RUN()) fox_scan_phase(lds, LF, CUM, G, bid);
                    SEAM();
                    if (RUN()) { AttnArgs a{QO, KB, VB, XB, nullptr, nullptr, CUM, nullptr}; for (int rep = 0; rep < REP_ATTN; ++rep) attn_phase<1>(lds, a, G, bid); }
                    SEAM();
                } else {
                    if (RUN()) mla_norm_phase(CB, CQN, CKVN, KR, csm, G, bid);
                    SEAM();
                    if (RUN()) {
                        for (int gi = 0; gi < 2; ++gi) {
                            pg8::EpiProj E{}; E.QO = QO; E.KB = KB; E.VB = VB; E.csp = csp; E.csm = csm; E.X0 = QR; E.mode = 4 + gi; E.qscale = 0.10206207261596575f * LOG2E;
                            const int N = gi == 0 ? 1536 : 2048, K = gi == 0 ? 384 : 256;
                            pg8::Gemm g{gi == 0 ? CQN : CKVN, (const bf16_t*)(ws + (gi == 0 ? WS_WUQ : WS_WUKV)), M_TOK, N, K};
                            pg8::StaticOrder S; S.init(M_TOK, N, G, bid);
                            pg8::gemm_phase<pg8::EpiProj, pg8::StaticOrder, true, true>(lds, g, S, E);
                        }
                    }
                    SEAM();
                    if (RUN()) { AttnArgs a{QO, KB, VB, XB, QR, KR, nullptr, nullptr}; for (int rep = 0; rep < REP_ATTN; ++rep) attn_phase<2>(lds, a, G, bid); }
                    SEAM();
                }
            }
            if (RUN()) {
                const bf16_t* A = sub != 1 ? HB : XB; const int K = sub != 1 ? FFD : 1024;
                const bf16_t* Bt = (const bf16_t*)(lw + (sub == 0 ? W2_OFF0 : (sub == 2 ? W2_OFF1 : WOUT_OFF)));
                pg8::Gemm g{A, Bt, M_TOK, 1024, K};
                pg8::StaticOrder S; S.init(M_TOK, 1024, G, bid);
                pg8::EpiResid E{p.out, ALPHA_DN, sub != 1 ? 0.5f : 1.0f};
                pg8::gemm_phase<pg8::EpiResid, pg8::StaticOrder, true, true>(lds, g, S, E);
            }
            SEAM();
            if (RUN()) ln_phase(p.out, XB, p.in[5] + (size_t)(L * 3 + sub) * 1024, p.in[6] + (size_t)(L * 3 + sub) * 1024, G, bid);
            SEAM();
        }
    }
}
constexpr int N_PHASES = 46;

extern "C" void kernel_launch(void* const* d_in, const int* in_sizes, int n_in, void* d_out, int out_size, void* d_ws, size_t ws_size, hipStream_t stream) {
    static int grid = 0;
    if (grid == 0) {
        int dev = 0, cus = 0, per_cu = 0;
        hipGetDevice(&dev);
        hipDeviceGetAttribute(&cus, hipDeviceAttributeMultiprocessorCount, dev);
        if (hipFuncSetAttribute((const void*)mega, hipFuncAttributeMaxDynamicSharedMemorySize, LDS_BYTES) != hipSuccess) fprintf(stderr, "kernel_launch: hipFuncSetAttribute failed\n");
        if (hipOccupancyMaxActiveBlocksPerMultiprocessor(&per_cu, (const void*)mega, 512, LDS_BYTES) != hipSuccess || per_cu < 1) { fprintf(stderr, "kernel_launch: occupancy query says %d\n", per_cu); per_cu = 1; }
        (void)hipGetLastError();
        grid = cus * 1;
        if (ws_size < 498 * MiB) fprintf(stderr, "kernel_launch: workspace too small: %zu\n", ws_size);
        if (n_in != 16) fprintf(stderr, "kernel_launch: expected 16 inputs, got %d\n", n_in);
    }
    (void)hipMemsetAsync(d_ws, 0, 65536, stream);
    Params p{};
    for (int i = 0; i < 16; ++i) p.in[i] = (const float*)d_in[i];
    p.out = (float*)d_out; p.ws = (unsigned char*)d_ws;
#if MK_MULTI
    for (int ph = 0; ph < N_PHASES; ++ph) { p.ph_lo = ph; p.ph_hi = ph + 1; hipLaunchKernelGGL(mega, dim3(grid), dim3(512), LDS_BYTES, stream, p); }
#else
    p.ph_lo = 0; p.ph_hi = 1 << 20;
    void* args[] = {&p};
    hipError_t e = hipLaunchCooperativeKernel((const void*)mega, dim3(grid), dim3(512), args, LDS_BYTES, stream);
    if (e != hipSuccess) fprintf(stderr, "cooperative launch failed: %s (grid %d)\n", hipGetErrorString(e), grid);
#endif
}
```
